# Optimizing an MI355X kernel written in HIP

```python
import jax, jax.numpy as jnp
from jax import lax
import numpy as np

D_MODEL = 2048
BATCH = 2
SEQ = 4096
DEPTH = 1

MIX_WIDTH = D_MODEL
NSA_HEADS = 8
NSA_KV_HEADS = 2
HEAD_DIM = MIX_WIDTH // 2 // NSA_HEADS
NSA_WIDTH = NSA_HEADS * HEAD_DIM
GQA_GROUP = NSA_HEADS // NSA_KV_HEADS
KV_WIDTH = NSA_KV_HEADS * HEAD_DIM
ROPE_DIM = HEAD_DIM // 4
ROPE_THETA = 500000.0
CMP_LEN = 32
CMP_STRIDE = 16
CMP_HIDDEN = 2 * HEAD_DIM
SEL_LEN = 64
SEL_TOPK = 16
WINDOW = 512
Q_BLOCK = 128
N_GATES = 3
LRU_WIDTH = MIX_WIDTH - NSA_WIDTH
LRU_BLOCKS = 8
LRU_BLOCK_DIM = LRU_WIDTH // LRU_BLOCKS
CONV_WIDTH = 4
LRU_C = 8.0
D_FF = 5632
PLE_DIM = 256
IN_WIDTH = NSA_WIDTH + 6 * KV_WIDTH + NSA_HEADS * N_GATES + 2 * LRU_WIDTH
RMS_EPS = 1e-6
NEG = -1e30
SEL_FORCE = 1e4

kernel_name = 'hybrid_nsa_rglru_macaron_block'


def rmsnorm(x, g):
    xf = x.astype(jnp.float32)
    y = xf * lax.rsqrt(jnp.mean(xf * xf, axis=-1, keepdims=True) + RMS_EPS)
    return (y * g.astype(jnp.float32)).astype(x.dtype)


def swiglu(x, w_gate, w_up, w_down):
    return (jax.nn.silu(x @ w_gate) * (x @ w_up)) @ w_down


def partial_rope(x, positions):
    half = ROPE_DIM // 2
    inv_freq = ROPE_THETA ** (-jnp.arange(half, dtype=jnp.float32) / half)
    ang = positions.astype(jnp.float32)[..., None] * inv_freq
    cos = jnp.cos(ang)[:, :, None, :]
    sin = jnp.sin(ang)[:, :, None, :]
    xr = x[..., :ROPE_DIM].astype(jnp.float32)
    x1, x2 = xr[..., :half], xr[..., half:]
    rot = jnp.concatenate([x1 * cos - x2 * sin, x2 * cos + x1 * sin], axis=-1)
    return jnp.concatenate([rot.astype(x.dtype), x[..., ROPE_DIM:]], axis=-1)


def masked_softmax(s, mask):
    s = jnp.where(mask, s.astype(jnp.float32), NEG)
    return jax.nn.softmax(s, axis=-1) * mask


def compress(kv, pos_emb, w1, w2):
    B, T, G, dh = kv.shape
    n_cmp = (T - CMP_LEN) // CMP_STRIDE + 1
    idx = jnp.arange(n_cmp)[:, None] * CMP_STRIDE + jnp.arange(CMP_LEN)[None, :]
    blocks = kv[:, idx] + pos_emb[:, None, :]
    blocks = blocks.transpose(0, 1, 3, 2, 4).reshape(B, n_cmp, G, CMP_LEN * dh)
    return jax.nn.gelu(blocks @ w1) @ w2


def nsa_attention(q, k_cmp, v_cmp, k_sel, v_sel, k_win, v_win, gates,
                  pos_k, pos_v, k_w1, k_w2, v_w1, v_w2):
    B, T = q.shape[:2]
    G, R, dh = NSA_KV_HEADS, GQA_GROUP, HEAD_DIM
    scale = HEAD_DIM ** -0.5
    kc = compress(k_cmp, pos_k, k_w1, k_w2)
    vc = compress(v_cmp, pos_v, v_w1, v_w2)
    n_cmp = kc.shape[1]
    cmp_start = jnp.arange(n_cmp) * CMP_STRIDE
    cmp_end = cmp_start + CMP_LEN - 1
    n_sel = T // SEL_LEN
    top_k = min(SEL_TOPK, n_sel)
    sel_start = jnp.arange(n_sel) * SEL_LEN
    overlap = ((cmp_start[:, None] < sel_start[None, :] + SEL_LEN)
               & (cmp_end[:, None] >= sel_start[None, :])).astype(jnp.float32)
    kb = k_sel.reshape(B, n_sel, SEL_LEN, G, dh).transpose(0, 3, 1, 2, 4)
    vb = v_sel.reshape(B, n_sel, SEL_LEN, G, dh).transpose(0, 3, 1, 2, 4)
    kw = jnp.pad(k_win, ((0, 0), (WINDOW, 0), (0, 0), (0, 0)))
    vw = jnp.pad(v_win, ((0, 0), (WINDOW, 0), (0, 0), (0, 0)))
    qg = q.reshape(B, T, G, R, dh)
    bi = jnp.arange(B)[:, None, None, None]
    gi = jnp.arange(G)[None, :, None, None]
    blk = jnp.arange(n_sel)

    def query_block(i):
        t0 = i * Q_BLOCK
        qb = lax.dynamic_slice_in_dim(qg, t0, Q_BLOCK, 1)
        gb = lax.dynamic_slice_in_dim(gates, t0, Q_BLOCK, 1).reshape(B, Q_BLOCK, G, R, N_GATES)
        t = t0 + jnp.arange(Q_BLOCK)
        s = jnp.einsum('btgrd,bcgd->bgrtc', qb, kc) * scale
        pc = masked_softmax(s, cmp_end[None, :] <= t[:, None])
        o_cmp = jnp.einsum('bgrtc,bcgd->btgrd', pc.astype(vc.dtype), vc)
        imp = jnp.einsum('bgrtc,cs->bgts', pc, overlap)
        forced = (blk[None, :] == (t // SEL_LEN)[:, None]) | (blk[None, :] == 0)
        valid = sel_start[None, :] <= t[:, None]
        imp = jnp.where(forced, SEL_FORCE, jnp.where(valid, imp, -SEL_FORCE))
        _, idx = lax.top_k(imp, top_k)
        ks = kb[bi, gi, idx]
        vs = vb[bi, gi, idx]
        kpos = idx[..., None] * SEL_LEN + jnp.arange(SEL_LEN)
        ms = (kpos <= t[:, None, None]).reshape(B, G, 1, Q_BLOCK, top_k * SEL_LEN)
        s = jnp.einsum('btgrd,bgtkjd->bgrtkj', qb, ks).reshape(B, G, R, Q_BLOCK, top_k * SEL_LEN) * scale
        ps = masked_softmax(s, ms).reshape(B, G, R, Q_BLOCK, top_k, SEL_LEN)
        o_sel = jnp.einsum('bgrtkj,bgtkjd->btgrd', ps.astype(vs.dtype), vs)
        kwb = lax.dynamic_slice_in_dim(kw, t0, WINDOW + Q_BLOCK, 1)
        vwb = lax.dynamic_slice_in_dim(vw, t0, WINDOW + Q_BLOCK, 1)
        kp = t0 - WINDOW + jnp.arange(WINDOW + Q_BLOCK)
        mw = (kp[None, :] <= t[:, None]) & (kp[None, :] > t[:, None] - WINDOW) & (kp[None, :] >= 0)
        s = jnp.einsum('btgrd,bsgd->bgrts', qb, kwb) * scale
        pw = masked_softmax(s, mw)
        o_win = jnp.einsum('bgrts,bsgd->btgrd', pw.astype(vwb.dtype), vwb)
        o = gb[..., 0, None] * o_cmp + gb[..., 1, None] * o_sel + gb[..., 2, None] * o_win
        return o.reshape(B, Q_BLOCK, NSA_WIDTH)

    out = lax.map(query_block, jnp.arange(T // Q_BLOCK))
    return out.transpose(1, 0, 2, 3).reshape(B, T, NSA_WIDTH)


def rglru_block(xb, yb, conv_w, conv_b, w_a, b_a, w_i, b_i, lam):
    B, T, C = xb.shape
    xc = lax.conv_general_dilated(xb, conv_w[:, None, :], window_strides=(1,),
                                  padding=[(CONV_WIDTH - 1, 0)],
                                  dimension_numbers=('NWC', 'WIO', 'NWC'),
                                  feature_group_count=C) + conv_b
    xh = xc.reshape(B, T, LRU_BLOCKS, LRU_BLOCK_DIM)
    r = jax.nn.sigmoid(jnp.einsum('bthi,hij->bthj', xh, w_a).reshape(B, T, C) + b_a)
    ig = jax.nn.sigmoid(jnp.einsum('bthi,hij->bthj', xh, w_i).reshape(B, T, C) + b_i)
    log_a = -LRU_C * r.astype(jnp.float32) * jax.nn.softplus(-lam.astype(jnp.float32))
    a = jnp.exp(log_a)
    u = jnp.sqrt(-jnp.expm1(2.0 * log_a)) * (ig * xc).astype(jnp.float32)

    def combine(left, right):
        a1, b1 = left
        a2, b2 = right
        return a1 * a2, a2 * b1 + b2

    _, h = lax.associative_scan(combine, (a, u), axis=1)
    return h.astype(xb.dtype) * jax.nn.gelu(yb)


def setup_inputs(seed: int = 0) -> dict:
    key = jax.random.key(seed)
    ks = iter(jax.random.split(key, 64))
    L = DEPTH
    f32 = jnp.float32

    def nrm(shape, fan_in):
        return jax.random.normal(next(ks), shape, f32) * fan_in ** -0.5

    def gain(shape):
        return 1.0 + 0.02 * jax.random.normal(next(ks), shape, f32)

    def small(shape, s=0.01):
        return s * jax.random.normal(next(ks), shape, f32)

    x = jax.random.normal(next(ks), (BATCH, SEQ, D_MODEL), f32)
    p = jax.random.normal(next(ks), (DEPTH, BATCH, SEQ, PLE_DIM), f32)
    positions = (jax.random.randint(next(ks), (BATCH, 1), 0, 1024) + jnp.arange(SEQ)[None, :]).astype(jnp.int32)
    d = {'x': x, 'p': p, 'positions': positions}
    d['ff1_pre_g'] = gain((L, D_MODEL))
    d['ff1_post_g'] = gain((L, D_MODEL))
    d['ff1_w_gate'] = nrm((L, D_MODEL, D_FF), D_MODEL)
    d['ff1_w_up'] = nrm((L, D_MODEL, D_FF), D_MODEL)
    d['ff1_w_down'] = nrm((L, D_FF, D_MODEL), D_FF)
    d['mix_pre_g'] = gain((L, D_MODEL))
    d['mix_post_g'] = gain((L, D_MODEL))
    d['w_in'] = nrm((L, D_MODEL, IN_WIDTH), D_MODEL)
    d['cmp_pos_k'] = small((L, CMP_LEN, HEAD_DIM), 0.1)
    d['cmp_pos_v'] = small((L, CMP_LEN, HEAD_DIM), 0.1)
    d['cmp_k_w1'] = nrm((L, CMP_LEN * HEAD_DIM, CMP_HIDDEN), CMP_LEN * HEAD_DIM)
    d['cmp_k_w2'] = nrm((L, CMP_HIDDEN, HEAD_DIM), CMP_HIDDEN)
    d['cmp_v_w1'] = nrm((L, CMP_LEN * HEAD_DIM, CMP_HIDDEN), CMP_LEN * HEAD_DIM)
    d['cmp_v_w2'] = nrm((L, CMP_HIDDEN, HEAD_DIM), CMP_HIDDEN)
    d['nsa_gate_b'] = small((L, NSA_HEADS, N_GATES))
    d['conv_w'] = nrm((L, CONV_WIDTH, LRU_WIDTH), CONV_WIDTH)
    d['conv_b'] = small((L, LRU_WIDTH))
    d['rg_w_a'] = nrm((L, LRU_BLOCKS, LRU_BLOCK_DIM, LRU_BLOCK_DIM), LRU_BLOCK_DIM)
    d['rg_b_a'] = small((L, LRU_WIDTH))
    d['rg_w_i'] = nrm((L, LRU_BLOCKS, LRU_BLOCK_DIM, LRU_BLOCK_DIM), LRU_BLOCK_DIM)
    d['rg_b_i'] = small((L, LRU_WIDTH))
    a_c = jax.random.uniform(next(ks), (L, LRU_WIDTH), f32, 0.9, 0.999)
    a0 = a_c ** (1.0 / LRU_C)
    d['rg_lambda'] = jnp.log(a0) - jnp.log1p(-a0)
    d['attn_out_g'] = gain((L, NSA_WIDTH))
    d['rec_out_g'] = gain((L, LRU_WIDTH))
    d['w_out'] = nrm((L, MIX_WIDTH, D_MODEL), MIX_WIDTH)
    d['ff2_pre_g'] = gain((L, D_MODEL))
    d['ff2_post_g'] = gain((L, D_MODEL))
    d['ff2_w_gate'] = nrm((L, D_MODEL, D_FF), D_MODEL)
    d['ff2_w_up'] = nrm((L, D_MODEL, D_FF), D_MODEL)
    d['ff2_w_down'] = nrm((L, D_FF, D_MODEL), D_FF)
    d['ple_pre_g'] = gain((L, D_MODEL))
    d['ple_post_g'] = gain((L, D_MODEL))
    d['w_ple_gate'] = nrm((L, D_MODEL, D_MODEL), D_MODEL)
    d['w_ple_proj'] = nrm((L, PLE_DIM, D_MODEL), PLE_DIM)
    return d


def reference(x, p, positions,
              ff1_pre_g, ff1_post_g, ff1_w_gate, ff1_w_up, ff1_w_down,
              mix_pre_g, mix_post_g, w_in,
              cmp_pos_k, cmp_pos_v, cmp_k_w1, cmp_k_w2, cmp_v_w1, cmp_v_w2, nsa_gate_b,
              conv_w, conv_b, rg_w_a, rg_b_a, rg_w_i, rg_b_i, rg_lambda,
              attn_out_g, rec_out_g, w_out,
              ff2_pre_g, ff2_post_g, ff2_w_gate, ff2_w_up, ff2_w_down,
              ple_pre_g, ple_post_g, w_ple_gate, w_ple_proj):
    B, T, _ = x.shape
    G = NSA_KV_HEADS
    offs = np.cumsum([NSA_WIDTH] + [KV_WIDTH] * 6 + [NSA_HEADS * N_GATES, LRU_WIDTH]).tolist()

    def heads(t, n):
        return t.reshape(B, T, n, HEAD_DIM)

    h = x
    for i in range(DEPTH):
        u = rmsnorm(h, ff1_pre_g[i])
        h = h + 0.5 * rmsnorm(swiglu(u, ff1_w_gate[i], ff1_w_up[i], ff1_w_down[i]), ff1_post_g[i])
        u = rmsnorm(h, mix_pre_g[i])
        z = u @ w_in[i]
        zq, zkc, zvc, zks, zvs, zkw, zvw, zg, zx, zy = jnp.split(z, offs, axis=-1)
        q = partial_rope(heads(zq, NSA_HEADS), positions)
        k_cmp = partial_rope(heads(zkc, G), positions)
        k_sel = partial_rope(heads(zks, G), positions)
        k_win = partial_rope(heads(zkw, G), positions)
        gates = jax.nn.sigmoid(zg.reshape(B, T, NSA_HEADS, N_GATES) + nsa_gate_b[i])
        o_attn = nsa_attention(q, k_cmp, heads(zvc, G), k_sel, heads(zvs, G), k_win, heads(zvw, G), gates,
                               cmp_pos_k[i], cmp_pos_v[i], cmp_k_w1[i], cmp_k_w2[i], cmp_v_w1[i], cmp_v_w2[i])
        o_rec = rglru_block(zx, zy, conv_w[i], conv_b[i], rg_w_a[i], rg_b_a[i],
                            rg_w_i[i], rg_b_i[i], rg_lambda[i])
        o = jnp.concatenate([rmsnorm(o_attn, attn_out_g[i]), rmsnorm(o_rec, rec_out_g[i])], axis=-1)
        h = h + rmsnorm(o @ w_out[i], mix_post_g[i])
        u = rmsnorm(h, ff2_pre_g[i])
        h = h + 0.5 * rmsnorm(swiglu(u, ff2_w_gate[i], ff2_w_up[i], ff2_w_down[i]), ff2_post_g[i])
        gate = jax.nn.sigmoid(rmsnorm(h, ple_pre_g[i]) @ w_ple_gate[i])
        h = h + rmsnorm(gate * (p[i] @ w_ple_proj[i]), ple_post_g[i])
    return h
```

```cpp
#include <hip/hip_runtime.h>
#include <math.h>
#include <stdio.h>

constexpr int D_MODEL = 2048, BATCH = 2, SEQ = 4096, MTOK = BATCH * SEQ;
constexpr int NH = 8, KVH = 2, HD = 128, NSA_W = 1024;
constexpr int N_CMP = 255, N_SEL = 64, TOPK = 16, WINDOW = 512;
constexpr int LRU_W = 1024;
constexpr int D_FF = 5632, PLE_DIM = 256, IN_W = 4632;
constexpr int C_Q = 0, C_KC = 1024, C_VC = 1280, C_KS = 1536, C_VS = 1792, C_KW = 2048, C_VW = 2304, C_G = 2560, C_ZX = 2584, C_ZY = 3608;
constexpr float RMS_EPS = 1e-6f;

__device__ __forceinline__ float wave_sum(float v) {
#pragma unroll
    for (int o = 32; o > 0; o >>= 1) v += __shfl_xor(v, o);
    return v;
}
__device__ __forceinline__ float wave_max(float v) {
#pragma unroll
    for (int o = 32; o > 0; o >>= 1) v = fmaxf(v, __shfl_xor(v, o));
    return v;
}
__device__ __forceinline__ float gelu_tanh(float x) {
    const float k0 = 0.7978845608028654f, k1 = 0.044715f;
    return 0.5f * x * (1.f + tanhf(k0 * (x + k1 * x * x * x)));
}
__device__ __forceinline__ float sigmoidf_(float x) { return 1.f / (1.f + expf(-x)); }

template <int MODE>
__global__ __launch_bounds__(256) void gemm_f32(const float* __restrict__ A, const float* __restrict__ B, const float* __restrict__ B2,
                                                float* __restrict__ C, int M, int N, int K, int lda, int ldb, int ldc, long sA, long sB, long sC) {
    A += (long)blockIdx.z * sA; B += (long)blockIdx.z * sB; C += (long)blockIdx.z * sC;
    if (MODE == 1) B2 += (long)blockIdx.z * sB;
    __shared__ float As[16][132];
    __shared__ float Bs[16][132];
    __shared__ float Bs2[MODE == 1 ? 16 : 1][132];
    const int tid = threadIdx.x, tx = tid & 15, ty = tid >> 4;
    const int bm = blockIdx.y * 128, bn = blockIdx.x * 128;
    float acc[8][8], acc2[MODE == 1 ? 8 : 1][8];
#pragma unroll
    for (int i = 0; i < 8; ++i)
#pragma unroll
        for (int j = 0; j < 8; ++j) { acc[i][j] = 0.f; if (MODE == 1) acc2[i][j] = 0.f; }
    const int arow = tid >> 1, ak = (tid & 1) * 8;
    const int bk = tid >> 4, bnn = (tid & 15) * 8;
    for (int k0 = 0; k0 < K; k0 += 16) {
        float4 a0 = make_float4(0, 0, 0, 0), a1 = a0;
        if (bm + arow < M) { const float* ap = A + (long)(bm + arow) * lda + k0 + ak; a0 = *(const float4*)ap; a1 = *(const float4*)(ap + 4); }
        float4 b0 = make_float4(0, 0, 0, 0), b1 = b0, c0 = b0, c1 = b0;
        { const float* bp = B + (long)(k0 + bk) * ldb + bn + bnn;
          if (bn + bnn < N) b0 = *(const float4*)bp;
          if (bn + bnn + 4 < N) b1 = *(const float4*)(bp + 4);
          if (MODE == 1) { const float* cp = B2 + (long)(k0 + bk) * ldb + bn + bnn;
              if (bn + bnn < N) c0 = *(const float4*)cp;
              if (bn + bnn + 4 < N) c1 = *(const float4*)(cp + 4); } }
        __syncthreads();
        As[ak + 0][arow] = a0.x; As[ak + 1][arow] = a0.y; As[ak + 2][arow] = a0.z; As[ak + 3][arow] = a0.w;
        As[ak + 4][arow] = a1.x; As[ak + 5][arow] = a1.y; As[ak + 6][arow] = a1.z; As[ak + 7][arow] = a1.w;
        *(float4*)&Bs[bk][bnn] = b0; *(float4*)&Bs[bk][bnn + 4] = b1;
        if (MODE == 1) { *(float4*)&Bs2[bk][bnn] = c0; *(float4*)&Bs2[bk][bnn + 4] = c1; }
        __syncthreads();
#pragma unroll
        for (int kk = 0; kk < 16; ++kk) {
            float a[8], b[8], b2[8];
            *(float4*)&a[0] = *(const float4*)&As[kk][ty * 4]; *(float4*)&a[4] = *(const float4*)&As[kk][64 + ty * 4];
            *(float4*)&b[0] = *(const float4*)&Bs[kk][tx * 4]; *(float4*)&b[4] = *(const float4*)&Bs[kk][64 + tx * 4];
            if (MODE == 1) { *(float4*)&b2[0] = *(const float4*)&Bs2[kk][tx * 4]; *(float4*)&b2[4] = *(const float4*)&Bs2[kk][64 + tx * 4]; }
#pragma unroll
            for (int i = 0; i < 8; ++i)
#pragma unroll
                for (int j = 0; j < 8; ++j) { acc[i][j] = fmaf(a[i], b[j], acc[i][j]); if (MODE == 1) acc2[i][j] = fmaf(a[i], b2[j], acc2[i][j]); }
        }
    }
#pragma unroll
    for (int i = 0; i < 8; ++i) {
        const int row = bm + (i < 4 ? ty * 4 + i : 64 + ty * 4 + (i - 4));
        if (row >= M) continue;
#pragma unroll
        for (int j = 0; j < 8; ++j) {
            const int col = bn + (j < 4 ? tx * 4 + j : 64 + tx * 4 + (j - 4));
            if (col >= N) continue;
            float v = acc[i][j];
            if (MODE == 1) { const float g = v; v = g / (1.f + expf(-g)) * acc2[i][j]; }
            C[(long)row * ldc + col] = v;
        }
    }
}

__global__ __launch_bounds__(256) void rmsnorm_k(const float* __restrict__ in, int ld_in, const float* __restrict__ g, float* __restrict__ out, int ld_out, int D) {
    const int row = blockIdx.x, tid = threadIdx.x;
    const float* x = in + (long)row * ld_in;
    float s = 0.f;
    for (int i = tid; i < D; i += 256) { const float v = x[i]; s += v * v; }
    __shared__ float red[4];
    s = wave_sum(s);
    if ((tid & 63) == 0) red[tid >> 6] = s;
    __syncthreads();
    const float tot = red[0] + red[1] + red[2] + red[3];
    const float r = rsqrtf(tot / (float)D + RMS_EPS);
    float* o = out + (long)row * ld_out;
    for (int i = tid; i < D; i += 256) o[i] = x[i] * r * g[i];
}
__global__ __launch_bounds__(256) void resid_norm_k(const float* hin, const float* __restrict__ y, const float* __restrict__ g, float scale, float* hout) {
    const int row = blockIdx.x, tid = threadIdx.x;
    const float* yr = y + (long)row * D_MODEL;
    float s = 0.f;
    for (int i = tid; i < D_MODEL; i += 256) { const float v = yr[i]; s += v * v; }
    __shared__ float red[4];
    s = wave_sum(s);
    if ((tid & 63) == 0) red[tid >> 6] = s;
    __syncthreads();
    const float tot = red[0] + red[1] + red[2] + red[3];
    const float r = rsqrtf(tot / (float)D_MODEL + RMS_EPS);
    for (int i = tid; i < D_MODEL; i += 256) hout[(long)row * D_MODEL + i] = hin[(long)row * D_MODEL + i] + scale * (yr[i] * r * g[i]);
}

__global__ __launch_bounds__(256) void rope_gate_k(float* __restrict__ z, const int* __restrict__ positions, const float* __restrict__ gate_b) {
    const int row = blockIdx.x, tid = threadIdx.x;
    float* zr = z + (long)row * IN_W;
    const float pos = (float)positions[row];
    if (tid < 224) {
        const int slot = tid >> 4, i = tid & 15;
        int col0;
        if (slot < 8) col0 = C_Q + slot * HD;
        else if (slot < 10) col0 = C_KC + (slot - 8) * HD;
        else if (slot < 12) col0 = C_KS + (slot - 10) * HD;
        else col0 = C_KW + (slot - 12) * HD;
        const float inv_freq = powf(500000.0f, -(float)i / 16.0f);
        const float ang = pos * inv_freq;
        float sn, cs; sincosf(ang, &sn, &cs);
        const float x1 = zr[col0 + i], x2 = zr[col0 + 16 + i];
        zr[col0 + i] = x1 * cs - x2 * sn;
        zr[col0 + 16 + i] = x2 * cs + x1 * sn;
    } else if (tid < 224 + 24) {
        const int j = tid - 224;
        zr[C_G + j] = sigmoidf_(zr[C_G + j] + gate_b[j]);
    }
}

__global__ __launch_bounds__(256) void cmp_gather_k(const float* __restrict__ z, int col0, const float* __restrict__ pos_emb, float* __restrict__ Acmp) {
    const int r = blockIdx.x;
    const int g = r & 1, bc = r >> 1, c = bc % N_CMP, b = bc / N_CMP;
    for (int i = threadIdx.x; i < 4096; i += 256) {
        const int l = i >> 7, d = i & 127;
        const int t = c * 16 + l;
        Acmp[(long)r * 4096 + i] = z[(long)(b * SEQ + t) * IN_W + col0 + g * HD + d] + pos_emb[l * HD + d];
    }
}
__global__ void gelu_k(float* __restrict__ x, long n) {
    const long i = (long)blockIdx.x * blockDim.x + threadIdx.x;
    if (i < n) x[i] = gelu_tanh(x[i]);
}

__global__ __launch_bounds__(256) void attn_v0(const float* __restrict__ z, const float* __restrict__ kc, const float* __restrict__ vc, float* __restrict__ o_attn) {
    const int bid = blockIdx.x, t = bid % SEQ, g = (bid / SEQ) % KVH, b = bid / (SEQ * KVH);
    const int tid = threadIdx.x, r = tid >> 6, l = tid & 63, h = g * 4 + r;
    const long row = (long)b * SEQ + t;
    const float* zr = z + row * IN_W;
    __shared__ float q_s[4][128];
    __shared__ float pc_s[4][256];
    __shared__ float p_s[4][1024];
    __shared__ float imp_s[64];
    __shared__ int sel_s[16];
    const float scale = 0.08838834764831845f;
    q_s[r][l] = zr[C_Q + h * HD + l]; q_s[r][l + 64] = zr[C_Q + h * HD + l + 64];
    __syncthreads();
    const float4* q4 = (const float4*)q_s[r];
    float oc0 = 0.f, oc1 = 0.f;
    {
        float sc[4]; bool vm[4]; float mx = -INFINITY;
#pragma unroll
        for (int k = 0; k < 4; ++k) {
            const int c = l + 64 * k;
            vm[k] = (c < N_CMP) && (16 * c + 31 <= t);
            float d = 0.f;
            if (vm[k]) { const float4* kp = (const float4*)(kc + ((long)(b * N_CMP + c) * KVH + g) * HD);
                for (int i = 0; i < 32; ++i) { const float4 a = q4[i], bb = kp[i]; d += a.x * bb.x + a.y * bb.y + a.z * bb.z + a.w * bb.w; } }
            sc[k] = d * scale;
            if (vm[k]) mx = fmaxf(mx, sc[k]);
        }
        mx = wave_max(mx);
        float e[4], sum = 0.f;
#pragma unroll
        for (int k = 0; k < 4; ++k) { e[k] = vm[k] ? expf(sc[k] - mx) : 0.f; sum += e[k]; }
        sum = wave_sum(sum);
        const float inv = sum > 0.f ? 1.f / sum : 0.f;
#pragma unroll
        for (int k = 0; k < 4; ++k) pc_s[r][l + 64 * k] = e[k] * inv;
        __syncthreads();
        const int cmax = (t >= 31) ? (t - 31) / 16 : -1;
        for (int c = 0; c <= cmax; ++c) { const float p = pc_s[r][c]; const float2 v = *(const float2*)(vc + ((long)(b * N_CMP + c) * KVH + g) * HD + 2 * l); oc0 += p * v.x; oc1 += p * v.y; }
    }
    if (tid < 64) {
        const int s = tid; float v = 0.f;
        const int c_lo = (4 * s - 1 < 0) ? 0 : 4 * s - 1, c_hi = (4 * s + 3 > N_CMP - 1) ? N_CMP - 1 : 4 * s + 3;
        for (int c = c_lo; c <= c_hi; ++c) v += (pc_s[0][c] + pc_s[1][c]) + (pc_s[2][c] + pc_s[3][c]);
        const bool forced = (s == t / 64) || (s == 0), valid = (64 * s <= t);
        imp_s[s] = forced ? 1e4f : (valid ? v : -1e4f);
    }
    __syncthreads();
    if (tid < 64) {
        const int s = tid; const float v = imp_s[s]; int rank = 0;
        for (int s2 = 0; s2 < 64; ++s2) { const float w = imp_s[s2]; rank += (w > v || (w == v && s2 < s)) ? 1 : 0; }
        if (rank < TOPK) sel_s[rank] = s;
    }
    __syncthreads();
    float os0 = 0.f, os1 = 0.f;
    {
        float ss[16]; float mx = -INFINITY;
#pragma unroll
        for (int e = 0; e < 16; ++e) {
            const int j = sel_s[e], pos = 64 * j + l; const bool ok = pos <= t;
            float d = 0.f;
            if (ok) { const float4* kp = (const float4*)(z + (long)(b * SEQ + pos) * IN_W + C_KS + g * HD);
                for (int i = 0; i < 32; ++i) { const float4 a = q4[i], bb = kp[i]; d += a.x * bb.x + a.y * bb.y + a.z * bb.z + a.w * bb.w; } }
            ss[e] = ok ? d * scale : -INFINITY;
            mx = fmaxf(mx, ss[e]);
        }
        mx = wave_max(mx);
        float sum = 0.f;
#pragma unroll
        for (int e = 0; e < 16; ++e) { const float ev = (ss[e] == -INFINITY) ? 0.f : expf(ss[e] - mx); sum += ev; p_s[r][e * 64 + l] = ev; }
        sum = wave_sum(sum);
        const float inv = 1.f / sum;
        __syncthreads();
        for (int e = 0; e < 16; ++e) {
            const int j = sel_s[e];
            if (64 * j > t) continue;
            for (int kk = 0; kk < 64; ++kk) { const int pos = 64 * j + kk; if (pos > t) break;
                const float p = p_s[r][e * 64 + kk]; const float2 v = *(const float2*)(z + (long)(b * SEQ + pos) * IN_W + C_VS + g * HD + 2 * l); os0 += p * v.x; os1 += p * v.y; }
        }
        os0 *= inv; os1 *= inv;
    }
    __syncthreads();
    float ow0 = 0.f, ow1 = 0.f;
    {
        float ss[8]; float mx = -INFINITY;
#pragma unroll
        for (int k = 0; k < 8; ++k) {
            const int pos = t - (WINDOW - 1) + l + 64 * k; const bool ok = pos >= 0;
            float d = 0.f;
            if (ok) { const float4* kp = (const float4*)(z + (long)(b * SEQ + pos) * IN_W + C_KW + g * HD);
                for (int i = 0; i < 32; ++i) { const float4 a = q4[i], bb = kp[i]; d += a.x * bb.x + a.y * bb.y + a.z * bb.z + a.w * bb.w; } }
            ss[k] = ok ? d * scale : -INFINITY;
            mx = fmaxf(mx, ss[k]);
        }
        mx = wave_max(mx);
        float sum = 0.f;
#pragma unroll
        for (int k = 0; k < 8; ++k) { const float ev = (ss[k] == -INFINITY) ? 0.f : expf(ss[k] - mx); sum += ev; p_s[r][k * 64 + l] = ev; }
        sum = wave_sum(sum);
        const float inv = 1.f / sum;
        __syncthreads();
        for (int kk = 0; kk < WINDOW; ++kk) { const int pos = t - (WINDOW - 1) + kk; if (pos < 0) continue;
            const float p = p_s[r][kk]; const float2 v = *(const float2*)(z + (long)(b * SEQ + pos) * IN_W + C_VW + g * HD + 2 * l); ow0 += p * v.x; ow1 += p * v.y; }
        ow0 *= inv; ow1 *= inv;
    }
    const float g0 = zr[C_G + h * 3 + 0], g1 = zr[C_G + h * 3 + 1], g2 = zr[C_G + h * 3 + 2];
    float2 o; o.x = g0 * oc0 + g1 * os0 + g2 * ow0; o.y = g0 * oc1 + g1 * os1 + g2 * ow1;
    *(float2*)(o_attn + row * NSA_W + h * HD + 2 * l) = o;
}

__global__ __launch_bounds__(256) void conv_k(const float* __restrict__ z, const float* __restrict__ conv_w, const float* __restrict__ conv_b, float* __restrict__ xc) {
    const int row = blockIdx.x, t = row % SEQ;
    for (int c = threadIdx.x; c < LRU_W; c += 256) {
        float v = conv_b[c];
#pragma unroll
        for (int w = 0; w < 4; ++w) { const int tt = t - 3 + w; if (tt >= 0) v += conv_w[w * LRU_W + c] * z[(long)(row - 3 + w) * IN_W + C_ZX + c]; }
        xc[(long)row * LRU_W + c] = v;
    }
}
__global__ __launch_bounds__(256) void lru_au_k(float* __restrict__ ra, float* __restrict__ ig, const float* __restrict__ xc, const float* __restrict__ b_a, const float* __restrict__ b_i, const float* __restrict__ lam) {
    const long i = (long)blockIdx.x * 256 + threadIdx.x; const int c = (int)(i % LRU_W);
    const float r = sigmoidf_(ra[i] + b_a[c]), g = sigmoidf_(ig[i] + b_i[c]);
    const float nl = -lam[c];
    const float sp = (nl > 20.f) ? nl : log1pf(expf(nl));
    const float log_a = -8.0f * r * sp;
    ra[i] = expf(log_a);
    ig[i] = sqrtf(-expm1f(2.0f * log_a)) * (g * xc[i]);
}
__global__ __launch_bounds__(64) void lru_scan_k(const float* __restrict__ a, const float* __restrict__ u, const float* __restrict__ z, float* __restrict__ orec) {
    const int idx = blockIdx.x * 64 + threadIdx.x; const int b = idx / LRU_W, c = idx % LRU_W;
    float h = 0.f;
    for (int t0 = 0; t0 < SEQ; t0 += 8) {
        float av[8], uv[8], yv[8];
#pragma unroll
        for (int k = 0; k < 8; ++k) { const long row = (long)b * SEQ + t0 + k; av[k] = a[row * LRU_W + c]; uv[k] = u[row * LRU_W + c]; yv[k] = z[row * IN_W + C_ZY + c]; }
#pragma unroll
        for (int k = 0; k < 8; ++k) { const long row = (long)b * SEQ + t0 + k; h = av[k] * h + uv[k]; orec[row * LRU_W + c] = h * gelu_tanh(yv[k]); }
    }
}

__global__ void ple_mul_k(float* __restrict__ gl, const float* __restrict__ pp, long n) {
    const long i = (long)blockIdx.x * blockDim.x + threadIdx.x;
    if (i < n) gl[i] = sigmoidf_(gl[i]) * pp[i];
}

static void gemm(hipStream_t s, const float* A, const float* B, float* C, int M, int N, int K, int lda, int ldb, int ldc, int batch = 1, long sA = 0, long sB = 0, long sC = 0) {
    dim3 grid((N + 127) / 128, (M + 127) / 128, batch);
    gemm_f32<0><<<grid, 256, 0, s>>>(A, B, nullptr, C, M, N, K, lda, ldb, ldc, sA, sB, sC);
}

extern "C" void kernel_launch(void* const* d_in, const int* in_sizes, int n_in, void* d_out, int out_size, void* d_ws, size_t ws_size, hipStream_t stream) {
    if (n_in != 37 || out_size != MTOK * D_MODEL) { fprintf(stderr, "kernel_launch: unexpected n_in %d / out_size %d\n", n_in, out_size); return; }
    auto F = [&](int i) { return (const float*)d_in[i]; };
    const float* x = F(0); const float* p = F(1); const int* positions = (const int*)d_in[2];
    float* h = (float*)d_out;
    float* ws = (float*)d_ws; size_t off = 0;
    auto take = [&](size_t n) { float* r = ws + off; off += (n + 63) & ~(size_t)63; return r; };
    float* u = take((size_t)MTOK * D_MODEL);
    float* act = take((size_t)MTOK * D_FF);
    float* y = take((size_t)MTOK * D_MODEL);
    float* ex = take((size_t)MTOK * LRU_W);
    float* Acmp = take((size_t)1020 * 4096);
    float* hid = take((size_t)1020 * 256);
    float* kc = take((size_t)1020 * 128);
    float* vc = take((size_t)1020 * 128);
    if (off * 4 > ws_size) { fprintf(stderr, "kernel_launch: workspace too small (%zu needed, %zu given)\n", off * 4, ws_size); return; }

    rmsnorm_k<<<MTOK, 256, 0, stream>>>(x, D_MODEL, F(3), u, D_MODEL, D_MODEL);
    { dim3 grid(D_FF / 128, MTOK / 128, 1); gemm_f32<1><<<grid, 256, 0, stream>>>(u, F(5), F(6), act, MTOK, D_FF, D_MODEL, D_MODEL, D_FF, D_FF, 0, 0, 0); }
    gemm(stream, act, F(7), y, MTOK, D_MODEL, D_FF, D_FF, D_MODEL, D_MODEL);
    resid_norm_k<<<MTOK, 256, 0, stream>>>(x, y, F(4), 0.5f, h);
    rmsnorm_k<<<MTOK, 256, 0, stream>>>(h, D_MODEL, F(8), u, D_MODEL, D_MODEL);
    float* z = act;
    gemm(stream, u, F(10), z, MTOK, IN_W, D_MODEL, D_MODEL, IN_W, IN_W);
    rope_gate_k<<<MTOK, 256, 0, stream>>>(z, positions, F(17));
    cmp_gather_k<<<1020, 256, 0, stream>>>(z, C_KC, F(11), Acmp);
    gemm(stream, Acmp, F(13), hid, 1020, 256, 4096, 4096, 256, 256);
    gelu_k<<<(1020 * 256 + 255) / 256, 256, 0, stream>>>(hid, 1020L * 256);
    gemm(stream, hid, F(14), kc, 1020, 128, 256, 256, 128, 128);
    cmp_gather_k<<<1020, 256, 0, stream>>>(z, C_VC, F(12), Acmp);
    gemm(stream, Acmp, F(15), hid, 1020, 256, 4096, 4096, 256, 256);
    gelu_k<<<(1020 * 256 + 255) / 256, 256, 0, stream>>>(hid, 1020L * 256);
    gemm(stream, hid, F(16), vc, 1020, 128, 256, 256, 128, 128);
    float* o_cat = u;
    float* o_attn = y;
    attn_v0<<<BATCH * KVH * SEQ, 256, 0, stream>>>(z, kc, vc, o_attn);
    rmsnorm_k<<<MTOK, 256, 0, stream>>>(o_attn, NSA_W, F(25), o_cat, D_MODEL, NSA_W);
    float* xc = y;
    float* ra = y + (size_t)MTOK * LRU_W;
    float* ig = ex;
    conv_k<<<MTOK, 256, 0, stream>>>(z, F(18), F(19), xc);
    gemm(stream, xc, F(20), ra, MTOK, 128, 128, LRU_W, 128, LRU_W, 8, 128, 128 * 128, 128);
    gemm(stream, xc, F(22), ig, MTOK, 128, 128, LRU_W, 128, LRU_W, 8, 128, 128 * 128, 128);
    lru_au_k<<<MTOK * LRU_W / 256, 256, 0, stream>>>(ra, ig, xc, F(21), F(23), F(24));
    lru_scan_k<<<BATCH * LRU_W / 64, 64, 0, stream>>>(ra, ig, z, xc);
    rmsnorm_k<<<MTOK, 256, 0, stream>>>(xc, LRU_W, F(26), o_cat + NSA_W, D_MODEL, LRU_W);
    gemm(stream, o_cat, F(27), act, MTOK, D_MODEL, D_MODEL, D_MODEL, D_MODEL, D_MODEL);
    resid_norm_k<<<MTOK, 256, 0, stream>>>(h, act, F(9), 1.0f, h);
    rmsnorm_k<<<MTOK, 256, 0, stream>>>(h, D_MODEL, F(28), u, D_MODEL, D_MODEL);
    { dim3 grid(D_FF / 128, MTOK / 128, 1); gemm_f32<1><<<grid, 256, 0, stream>>>(u, F(30), F(31), act, MTOK, D_FF, D_MODEL, D_MODEL, D_FF, D_FF, 0, 0, 0); }
    gemm(stream, act, F(32), y, MTOK, D_MODEL, D_FF, D_FF, D_MODEL, D_MODEL);
    resid_norm_k<<<MTOK, 256, 0, stream>>>(h, y, F(29), 0.5f, h);
    rmsnorm_k<<<MTOK, 256, 0, stream>>>(h, D_MODEL, F(33), u, D_MODEL, D_MODEL);
    gemm(stream, u, F(35), y, MTOK, D_MODEL, D_MODEL, D_MODEL, D_MODEL, D_MODEL);
    gemm(stream, p, F(36), act, MTOK, D_MODEL, PLE_DIM, PLE_DIM, D_MODEL, D_MODEL);
    ple_mul_k<<<(int)(((long)MTOK * D_MODEL + 255) / 256), 256, 0, stream>>>(y, act, (long)MTOK * D_MODEL);
    resid_norm_k<<<MTOK, 256, 0, stream>>>(h, y, F(34), 1.0f, h);
}
```

```cpp
#include <hip/hip_runtime.h>
#include <math.h>
#include <stdio.h>

constexpr int D_MODEL = 2048, BATCH = 2, SEQ = 4096, MTOK = BATCH * SEQ;
constexpr int NH = 8, KVH = 2, HD = 128, NSA_W = 1024;
constexpr int N_CMP = 255, N_SEL = 64, TOPK = 16, WINDOW = 512;
constexpr int LRU_W = 1024;
constexpr int D_FF = 5632, PLE_DIM = 256, IN_W = 4632;
constexpr int C_Q = 0, C_KC = 1024, C_VC = 1280, C_KS = 1536, C_VS = 1792, C_KW = 2048, C_VW = 2304, C_G = 2560, C_ZX = 2584, C_ZY = 3608;
constexpr float RMS_EPS = 1e-6f;

__device__ __forceinline__ float wave_sum(float v) {
#pragma unroll
    for (int o = 32; o > 0; o >>= 1) v += __shfl_xor(v, o);
    return v;
}
__device__ __forceinline__ float wave_max(float v) {
#pragma unroll
    for (int o = 32; o > 0; o >>= 1) v = fmaxf(v, __shfl_xor(v, o));
    return v;
}
__device__ __forceinline__ float gelu_tanh(float x) {
    const float k0 = 0.7978845608028654f, k1 = 0.044715f;
    return 0.5f * x * (1.f + tanhf(k0 * (x + k1 * x * x * x)));
}
__device__ __forceinline__ float sigmoidf_(float x) { return 1.f / (1.f + expf(-x)); }

#include <hip/hip_cooperative_groups.h>
#include <cstdint>
namespace pg8 {
#define PG8_LAS __attribute__((address_space(3)))
typedef unsigned short bf16_t;
typedef short bf16x8 __attribute__((ext_vector_type(8)));
typedef float f32x4 __attribute__((ext_vector_type(4)));
typedef unsigned u32x4 __attribute__((ext_vector_type(4)));
constexpr int BM = 256, BK = 64, HALF = 128, HTB = HALF * BK * 2  , STAGE_BYTES = 8 * HTB, NXCD = 8, WGM = 8;

__host__ __device__ __forceinline__ int lds_byte(int r, int c) { const int st = (r >> 4) * 2 + (c >> 5), rr = r & 15, cc = c & 31, ob = rr * 64 + cc * 2; return st * 1024 + (ob ^ (((ob >> 9) & 1) << 5)); }
__host__ __device__ __forceinline__ void stage_rc(int b, int& R, int& C) { const int st = b / 1024, sb = b % 1024, swz = sb ^ (((sb >> 9) & 1) << 5); R = (st >> 1) * 16 + swz / 64; C = (st & 1) * 32 + (swz % 64) / 2; }
__host__ __device__ __forceinline__ int perm32(int rho) { const int n = rho >> 4, i = rho & 15; return 8 * (i >> 2) + 4 * n + (i & 3); }

struct Unit { int pm, pn; };
struct Gemm { const bf16_t* A; const bf16_t* Bt; int M, N, K; };

struct StaticOrder {
    int nM, nN, nwg, G, c;
    __host__ __device__ void init(int M, int N, int G_, int c_) { nM = M / BM; nN = N / BM; nwg = nM * nN; G = G_; c = c_; }
    __host__ __device__ bool next(int i, Unit& u) const {
        const long L = (long)i * G + c; if (L >= nwg) return false;
        int wgid = (int)L; { const int q = nwg / NXCD, r = nwg % NXCD, xcd = wgid % NXCD, off = wgid / NXCD; wgid = (xcd < r ? xcd * (q + 1) : r * (q + 1) + (xcd - r) * q) + off; }
        const int nig = WGM * nN, gid = wgid / nig, fm = gid * WGM, gsz = (nM - fm) < WGM ? (nM - fm) : WGM;
        u.pm = fm + ((wgid % nig) % gsz); u.pn = (wgid % nig) / gsz; return true;
    }
    __device__ __forceinline__ void a_ready(const Unit&) const {}
    __device__ __forceinline__ void done(const Unit&) const {}
};

__device__ __forceinline__ unsigned cvt_pk_bf16(float lo, float hi) { unsigned r; asm volatile("v_cvt_pk_bf16_f32 %0, %1, %2" : "=v"(r) : "v"(lo), "v"(hi)); return r; }
typedef float f32x2 __attribute__((ext_vector_type(2)));
template <class Epi, class Sched, bool ALIGN_EPI = false, bool SP2 = false>
__device__ __forceinline__ void gemm_phase(PG8_LAS unsigned char* lds, const Gemm g, const Sched& S, const Epi& E) {
    const int tid = threadIdx.x, wid = __builtin_amdgcn_readfirstlane(tid >> 6), lane = tid & 63, wr = wid >> 2, wc = wid & 3, fr = lane & 15, fq = lane >> 4;
    const int K = g.K, nt = K / BK;
    unsigned voffA[2], voffB[2];
#pragma unroll
    for (int i = 0; i < 2; ++i) { int R, C; stage_rc(tid * 16 + i * 8192, R, C); const int Rb = Epi::PERM ? ((R & ~31) + perm32(R & 31)) : R;
        voffA[i] = (unsigned)(R * K + C) * 2u; voffB[i] = (unsigned)(Rb * K + C) * 2u; }
    const size_t kstep = (size_t)(BK * 2);
    const size_t hstep = (size_t)HALF * K * 2;
    const size_t tstep = 2 * hstep;
    const unsigned ldsw = (unsigned)wid * 1024u;
    const int aoff = lds_byte(wr * 64 + fr, fq * 8), boff = lds_byte(wc * 32 + fr, fq * 8);
#define PG8_SA(b, h) (((b) * 2 + (h)) * HTB)
#define PG8_SB(b, h) ((4 + (b) * 2 + (h)) * HTB)
#define PG8_STAGE(bufoff, gbase, voff) do { _Pragma("unroll") for (int _i = 0; _i < 2; ++_i) \
        __builtin_amdgcn_global_load_lds((const unsigned*)((const char*)(gbase) + (voff)[_i]), (PG8_LAS unsigned*)(lds + (bufoff) + ldsw + _i * 8192), 16, 0, 0); } while (0)
#define PG8_LDA(dst, b, h) do { _Pragma("unroll") for (int m = 0; m < 4; ++m) _Pragma("unroll") for (int k = 0; k < 2; ++k) dst[m][k] = *(const PG8_LAS bf16x8*)(lds + PG8_SA(b, h) + aoff + m * 2048 + k * 1024); } while (0)
#define PG8_LDB(dst, b, h) do { _Pragma("unroll") for (int n = 0; n < 2; ++n) _Pragma("unroll") for (int k = 0; k < 2; ++k) dst[n][k] = *(const PG8_LAS bf16x8*)(lds + PG8_SB(b, h) + boff + n * 2048 + k * 1024); } while (0)
#define PG8_MMA(ai, bj, At, Bt) do { __builtin_amdgcn_s_setprio(1); _Pragma("unroll") for (int m = 0; m < 4; ++m) _Pragma("unroll") for (int n = 0; n < 2; ++n) _Pragma("unroll") for (int k = 0; k < 2; ++k) \
        acc[ai][bj][m][n] = __builtin_amdgcn_mfma_f32_16x16x32_bf16(Bt[n][k], At[m][k], acc[ai][bj][m][n], 0, 0, 0); __builtin_amdgcn_s_setprio(0); } while (0)
#define PG8_WAIT_V(n) asm volatile("s_waitcnt vmcnt(" #n ")" ::: "memory")
#define PG8_WAIT_L(n) asm volatile("s_waitcnt lgkmcnt(" #n ")" ::: "memory")
#define PG8_BAR __builtin_amdgcn_s_barrier()
#define PG8_SCHED __builtin_amdgcn_sched_barrier(0)
    Unit cur, nxt; int ui = 0;
    if (!S.next(0, cur)) return;
    f32x4 acc[2][2][4][2];
#pragma unroll
    for (int a = 0; a < 2; ++a)
#pragma unroll
        for (int b = 0; b < 2; ++b)
#pragma unroll
            for (int m = 0; m < 4; ++m)
#pragma unroll
                for (int n = 0; n < 2; ++n) acc[a][b][m][n] = (f32x4){0.f, 0.f, 0.f, 0.f};
    bf16x8 At[4][2], B0[2][2], B1[2][2];
    const char* cA = (const char*)g.A + (size_t)cur.pm * tstep; const char* cB = (const char*)g.Bt + (size_t)cur.pn * tstep;
    S.a_ready(cur);
    if constexpr (SP2) {
        PG8_STAGE(PG8_SB(0, 0), cB, voffB); PG8_STAGE(PG8_SB(0, 1), cB + hstep, voffB); PG8_STAGE(PG8_SA(0, 0), cA, voffA); PG8_STAGE(PG8_SA(0, 1), cA + hstep, voffA);
        if (wr == 1) PG8_BAR;
        PG8_WAIT_V(2); PG8_BAR;
        PG8_STAGE(PG8_SB(1, 0), cB + kstep, voffB); PG8_STAGE(PG8_SA(1, 0), cA + kstep, voffA); PG8_STAGE(PG8_SB(1, 1), cB + hstep + kstep, voffB);
        PG8_WAIT_V(6); PG8_BAR;
    } else {
        PG8_STAGE(PG8_SB(0, 0), cB, voffB); PG8_STAGE(PG8_SA(0, 0), cA, voffA); PG8_STAGE(PG8_SB(0, 1), cB + hstep, voffB); PG8_STAGE(PG8_SA(0, 1), cA + hstep, voffA);
        if (wr == 1) PG8_BAR;
        PG8_WAIT_V(4); PG8_BAR;
        PG8_STAGE(PG8_SB(1, 0), cB + kstep, voffB); PG8_STAGE(PG8_SA(1, 0), cA + kstep, voffA); PG8_STAGE(PG8_SB(1, 1), cB + hstep + kstep, voffB);
        PG8_WAIT_V(6); PG8_BAR;
    }
    for (;;) {
        const bool has_next = S.next(ui + 1, nxt);
        const char* nA = has_next ? (const char*)g.A + (size_t)nxt.pm * tstep : cA; const char* nB = has_next ? (const char*)g.Bt + (size_t)nxt.pn * tstep : cB;
        for (int t = 0; t < nt; t += 2) {
            const bool last = (t == nt - 2);
            const char* a1 = cA + (size_t)(t + 1) * kstep;
            const char* a2 = last ? nA : cA + (size_t)(t + 2) * kstep; const char* b2 = last ? nB : cB + (size_t)(t + 2) * kstep;
            const char* a3 = a2 + kstep; const char* b3 = b2 + kstep;
            if (last && has_next) S.a_ready(nxt);
            if constexpr (SP2) {
            PG8_LDB(B0, 0, 0); PG8_LDB(B1, 0, 1); PG8_SCHED; PG8_LDA(At, 0, 0); PG8_STAGE(PG8_SA(1, 1), a1 + hstep, voffA);
            PG8_WAIT_V(8); PG8_WAIT_L(0); PG8_BAR; PG8_MMA(0, 0, At, B0); PG8_MMA(0, 1, At, B1); PG8_BAR; PG8_SCHED;
            PG8_LDA(At, 0, 1); PG8_STAGE(PG8_SB(0, 0), b2, voffB); PG8_STAGE(PG8_SB(0, 1), b2 + hstep, voffB); PG8_STAGE(PG8_SA(0, 0), a2, voffA);
            PG8_WAIT_V(8); PG8_WAIT_L(0); PG8_BAR; PG8_MMA(1, 0, At, B0); PG8_MMA(1, 1, At, B1); PG8_BAR; PG8_SCHED;
            PG8_LDB(B0, 1, 0); PG8_LDB(B1, 1, 1); PG8_SCHED; PG8_LDA(At, 1, 0); PG8_STAGE(PG8_SA(0, 1), a2 + hstep, voffA);
            PG8_WAIT_V(8); PG8_WAIT_L(0); PG8_BAR; PG8_MMA(0, 0, At, B0); PG8_MMA(0, 1, At, B1); PG8_BAR; PG8_SCHED;
            PG8_LDA(At, 1, 1); PG8_STAGE(PG8_SB(1, 0), b3, voffB); PG8_STAGE(PG8_SB(1, 1), b3 + hstep, voffB); PG8_STAGE(PG8_SA(1, 0), a3, voffA);
            PG8_WAIT_V(8); PG8_WAIT_L(0); PG8_BAR; PG8_MMA(1, 0, At, B0); PG8_MMA(1, 1, At, B1); PG8_BAR; PG8_SCHED;
            } else {
            PG8_LDB(B0, 0, 0); PG8_SCHED; PG8_LDA(At, 0, 0); PG8_STAGE(PG8_SA(1, 1), a1 + hstep, voffA);
            PG8_WAIT_L(8); PG8_BAR; PG8_WAIT_L(0); PG8_MMA(0, 0, At, B0); PG8_BAR; PG8_SCHED;
            PG8_LDB(B1, 0, 1); PG8_STAGE(PG8_SB(0, 0), b2, voffB);
            PG8_BAR; PG8_WAIT_L(0); PG8_MMA(0, 1, At, B1); PG8_BAR;
            PG8_LDA(At, 0, 1); PG8_STAGE(PG8_SA(0, 0), a2, voffA);
            PG8_BAR; PG8_WAIT_L(0); PG8_MMA(1, 0, At, B0); PG8_BAR; PG8_SCHED;
            PG8_STAGE(PG8_SB(0, 1), b2 + hstep, voffB);
            PG8_WAIT_V(6); PG8_BAR; PG8_MMA(1, 1, At, B1); PG8_BAR;
            PG8_LDB(B0, 1, 0); PG8_SCHED; PG8_LDA(At, 1, 0); PG8_STAGE(PG8_SA(0, 1), a2 + hstep, voffA);
            PG8_WAIT_L(8); PG8_BAR; PG8_WAIT_L(0); PG8_MMA(0, 0, At, B0); PG8_BAR; PG8_SCHED;
            PG8_LDB(B1, 1, 1); PG8_STAGE(PG8_SB(1, 0), b3, voffB);
            PG8_BAR; PG8_WAIT_L(0); PG8_MMA(0, 1, At, B1); PG8_BAR;
            PG8_LDA(At, 1, 1); PG8_STAGE(PG8_SA(1, 0), a3, voffA);
            PG8_BAR; PG8_WAIT_L(0); PG8_MMA(1, 0, At, B0); PG8_BAR; PG8_SCHED;
            PG8_STAGE(PG8_SB(1, 1), b3 + hstep, voffB);
            PG8_WAIT_V(6); PG8_BAR; PG8_MMA(1, 1, At, B1); PG8_BAR;
            }
        }
        if constexpr (ALIGN_EPI) { if (wr == 0) PG8_BAR; }
        if constexpr (!Epi::AFTER_DRAIN) { E(acc, cur, wr, wc, fr, fq); S.done(cur); }
        if (!has_next) break;
#pragma unroll
        for (int a = 0; a < 2; ++a)
#pragma unroll
            for (int b = 0; b < 2; ++b)
#pragma unroll
                for (int m = 0; m < 4; ++m)
#pragma unroll
                    for (int n = 0; n < 2; ++n) acc[a][b][m][n] = (f32x4){0.f, 0.f, 0.f, 0.f};
        cur = nxt; cA = nA; cB = nB; ++ui;
        if constexpr (ALIGN_EPI) { if (wr == 1) PG8_BAR; }
    }
    PG8_WAIT_V(0);
    if constexpr (!ALIGN_EPI) { if (wr == 0) PG8_BAR; }
    PG8_BAR;
    if constexpr (Epi::AFTER_DRAIN) { E.fused(acc, cur, wr, wc, fr, fq, lds, wid, lane); S.done(cur); }
#undef PG8_SA
#undef PG8_SB
#undef PG8_STAGE
#undef PG8_LDA
#undef PG8_LDB
#undef PG8_MMA
#undef PG8_WAIT_V
#undef PG8_WAIT_L
#undef PG8_BAR
#undef PG8_SCHED
}
}
#define GAS __attribute__((address_space(1)))
#define LAS __attribute__((address_space(3)))
typedef unsigned short bf16;
typedef unsigned v4u __attribute__((ext_vector_type(4)));
typedef float f32x4 __attribute__((ext_vector_type(4)));
typedef short bf16x8 __attribute__((ext_vector_type(8)));
typedef GAS unsigned gu32;
typedef GAS unsigned long long gu64;
#define RLX_AGENT __ATOMIC_RELAXED, __HIP_MEMORY_SCOPE_AGENT
#define LDS_WAIT() asm volatile("s_waitcnt lgkmcnt(0)" ::: "memory")
#define VM_WAIT() asm volatile("s_waitcnt vmcnt(0)" ::: "memory")
__device__ __forceinline__ unsigned long long rt() { return __builtin_amdgcn_s_memrealtime(); }
__device__ __forceinline__ unsigned f2bf(float f) { unsigned u = __builtin_bit_cast(unsigned, f); return (u + 0x7fffu + ((u >> 16) & 1u)) >> 16; }
__device__ __forceinline__ unsigned pk2(float lo, float hi) { return f2bf(lo) | (f2bf(hi) << 16); }
#define XB_TMO      128
#define XB_XCNT(j)  (256  + 64 * (j))
#define XB_XSUB(j)  (1280 + 64 * (j))
#define XB_XGEN(j)  (2304 + 64 * (j))
#define XB_TOP      3328
#define XB_TOPGEN   3392
#define XCD_BAR_WORDS 3456
#define XB_SPIN_CAP (1u << 18)

__device__ __forceinline__ unsigned xb_ld(unsigned* p)              { return __hip_atomic_load(p, __ATOMIC_RELAXED, __HIP_MEMORY_SCOPE_AGENT); }
__device__ __forceinline__ unsigned xb_add(unsigned* p, unsigned v) { return __hip_atomic_fetch_add(p, v, __ATOMIC_RELAXED, __HIP_MEMORY_SCOPE_AGENT); }
__device__ __forceinline__ unsigned xb_xcc_id() { return (unsigned)__builtin_amdgcn_s_getreg((3 << 11) | 20) & 0xFu; }
#define XB_SPIN(cond, bar) do { unsigned _sp = 0; while (cond) { __builtin_amdgcn_s_sleep(1); \
    if ((++_sp & 255u) == 0u) { if (xb_ld(&(bar)[XB_TMO])) break; if (_sp > XB_SPIN_CAP) { atomicAdd(&(bar)[XB_TMO], 1u); break; } } } } while (0)

struct XcdBarrier {
    unsigned* bar; unsigned x;
    volatile LAS unsigned* st;
};

__device__ __forceinline__ XcdBarrier xcd_barrier_post(unsigned* bar, volatile LAS unsigned* st) {
    XcdBarrier b; b.bar = bar; b.x = xb_xcc_id(); b.st = st;
    if (threadIdx.x == 0) (void)xb_add(&bar[XB_XCNT(b.x)], 1u);
    return b;
}
__device__ __forceinline__ void xcd_barrier_complete(unsigned* bar, unsigned x, unsigned& nloc, unsigned& nx) {
    const unsigned G = gridDim.x * gridDim.y * gridDim.z;
    unsigned sum, cnt, mine, sp = 0u;
    for (;;) {
        sum = 0u; cnt = 0u; mine = 0u;
#pragma unroll
        for (unsigned j = 0; j < 16; ++j) { const unsigned c = xb_ld(&bar[XB_XCNT(j)]); sum += c; cnt += (c > 0u) ? 1u : 0u; mine = (j == x) ? c : mine; }
        if (sum == G) break;
        __builtin_amdgcn_s_sleep(1);
        if ((++sp & 255u) == 0u) { if (xb_ld(&bar[XB_TMO])) break; if (sp > XB_SPIN_CAP) { atomicAdd(&bar[XB_TMO], 1u); break; } }
    }
    nloc = mine > 0u ? mine : 1u; nx = cnt > 0u ? cnt : 1u;
}

__device__ __forceinline__ void xcd_barrier(const XcdBarrier& b) {
    asm volatile("s_waitcnt vmcnt(0)" ::: "memory");
    __syncthreads();
    if (threadIdx.x == 0) {
        unsigned* bar = b.bar;
        __builtin_amdgcn_s_waitcnt(0);
        unsigned nloc = b.st[0], nx = b.st[1];
        if (nloc == 0u) { xcd_barrier_complete(bar, b.x, nloc, nx); b.st[0] = nloc; b.st[1] = nx; }
        const unsigned old = xb_add(&bar[XB_XSUB(b.x)], 1u);
        const unsigned gen = old / nloc;
        if (old + 1u == (gen + 1u) * nloc) {
            __builtin_amdgcn_fence(__ATOMIC_RELEASE, "agent");
            asm volatile("s_waitcnt vmcnt(0)" ::: "memory");
            const unsigned og = xb_add(&bar[XB_TOP], 1u);
            const unsigned tg = og / nx;
            if (og + 1u == (tg + 1u) * nx) xb_add(&bar[XB_TOPGEN], 1u);
            else XB_SPIN(xb_ld(&bar[XB_TOPGEN]) == tg, bar);
            __builtin_amdgcn_fence(__ATOMIC_ACQUIRE, "agent");
            xb_add(&bar[XB_XGEN(b.x)], 1u);
            asm volatile("s_waitcnt vmcnt(0)" ::: "memory");
        } else {
            XB_SPIN(xb_ld(&bar[XB_XGEN(b.x)]) == gen, bar);
            __builtin_amdgcn_fence(__ATOMIC_ACQUIRE, "agent");
            asm volatile("s_waitcnt vmcnt(0)" ::: "memory");
        }
    }
    __syncthreads();
}

namespace cg = cooperative_groups;
constexpr int NWAVES = 8;
constexpr size_t MiB = 1u << 20;
constexpr size_t WS_CTL = 0, CTL_ZERO_BYTES = 1 * MiB;
constexpr size_t WS_TAB = 1 * MiB;
constexpr size_t WS_SMALL = 2 * MiB;
constexpr size_t WS_WCMPK = 4 * MiB, WS_WCMPV = 6 * MiB;
constexpr size_t WS_WIN = 8 * MiB, WS_WOUT = 28 * MiB, WS_WPG = 36 * MiB, WS_WPP = 44 * MiB;
constexpr size_t WS_WF1GU = 46 * MiB, WS_WF1D = 90 * MiB, WS_WF2GU = 112 * MiB, WS_WF2D = 156 * MiB;
constexpr size_t WS_U = 178 * MiB, WS_ACT = 210 * MiB, WS_YZ = 298 * MiB, WS_KCVC = 378 * MiB, WS_P16 = 380 * MiB, WS_END = 384 * MiB;
constexpr size_t YZ_Q = 0, YZ_KV = 16 * MiB  , YZ_ZX = 40 * MiB, YZ_ZY = 56 * MiB, YZ_GATES = 72 * MiB;
constexpr int N_IN_PAD = 4864;
constexpr int CW_BAR = 4096;
constexpr int RING_OFF = 0, RING_BYTES = 143360;
constexpr int LDSCTL_OFF = RING_BYTES, MISC_OFF = LDSCTL_OFF + 320;
constexpr int LDS_BYTES = 147456;

struct Frame {
    LAS unsigned char* lds;
    volatile LAS unsigned* MISC;
    gu32* ctl;
    int tid, lane, wave;
    int vcu, G;
};

__device__ __forceinline__ float wave_sum_x(float v) {
#pragma unroll
    for (int o = 1; o < 64; o <<= 1) v += __shfl_xor(v, o);
    return v;
}
__device__ __forceinline__ void p0_tr_item(const float* W, int ldw, int k0, int src_n0, int ncv, bf16* WT, int ldwt, int dst_row0, LAS float* scr, int lane) {
    const int nn = lane & 31;
#pragma unroll 8
    for (int i = 0; i < 32; ++i) { const int kk = 2 * i + (lane >> 5); scr[kk * 33 + nn] = (nn < ncv) ? W[(size_t)(k0 + kk) * ldw + src_n0 + nn] : 0.f; }
    LDS_WAIT(); asm volatile("" ::: "memory");
    const int c = lane & 7;
#pragma unroll
    for (int j = 0; j < 4; ++j) { const int n = (lane >> 3) + 8 * j; const LAS float* s = scr + (8 * c) * 33 + n;
        v4u o; o.x = pk2(s[0 * 33], s[1 * 33]); o.y = pk2(s[2 * 33], s[3 * 33]); o.z = pk2(s[4 * 33], s[5 * 33]); o.w = pk2(s[6 * 33], s[7 * 33]);
        *(GAS v4u*)(WT + (size_t)(dst_row0 + n) * ldwt + k0 + 8 * c) = o; }
    LDS_WAIT(); asm volatile("" ::: "memory");
}
__device__ __forceinline__ void rms_row_to_bf16(const float* xrow, const float* g, bf16* orow, int lane) {
    const GAS f32x4* xr = (const GAS f32x4*)xrow + lane; const GAS f32x4* gr = (const GAS f32x4*)g + lane;
    f32x4 v[8]; float s = 0.f;
#pragma unroll
    for (int j = 0; j < 8; ++j) { v[j] = xr[64 * j]; s += (v[j].x * v[j].x + v[j].y * v[j].y) + (v[j].z * v[j].z + v[j].w * v[j].w); }
    const float r = 1.0f / sqrtf(wave_sum_x(s) * (1.f / D_MODEL) + RMS_EPS);
    GAS unsigned long long* o8 = (GAS unsigned long long*)orow + lane;
#pragma unroll
    for (int j = 0; j < 8; ++j) { const f32x4 gg = gr[64 * j];
        o8[64 * j] = (unsigned long long)pk2(v[j].x * r * gg.x, v[j].y * r * gg.y) | ((unsigned long long)pk2(v[j].z * r * gg.z, v[j].w * r * gg.w) << 32); }
}

struct Args { const void* in[37]; float* out; unsigned char* ws; int ph_lo, ph_hi, li, jobmask, sub, pad; };

struct TrJob { const float* W; int ldw, K, src0, ncols; bf16* WT; int mode, dst0; };
__device__ __forceinline__ int trjob_items(const TrJob& j) { return (j.K / 64) * ((j.ncols + 31) / 32); }
__device__ __forceinline__ void trjob_run(const TrJob& j, int item, LAS float* scr, int lane) {
    const int nblk = (j.ncols + 31) / 32, kb = item / nblk, nb = item % nblk, n0 = 32 * nb;
    const int ncv = (j.ncols - n0) < 32 ? (j.ncols - n0) : 32;
    const int drow = (j.mode == 1) ? (256 * (n0 / 128) + j.dst0 + (n0 % 128)) : (j.dst0 + n0);
    p0_tr_item(j.W, j.ldw, 64 * kb, j.src0 + n0, ncv, j.WT, j.K, drow, scr, lane);
}

enum { JM_FF1 = 1, JM_WIN = 2, JM_OUT = 4, JM_FF2 = 8, JM_MIX = 16, JM_ALL = 31 };
enum { SUB_CMP = 1, SUB_LRU = 2, SUB_ATT = 4, SUB_FIN = 8, SUB_ALL = 15 };
__device__ __forceinline__ void p0_mix(Frame& F, const Args& a);
__device__ __forceinline__ void p0_prologue(Frame& F, const Args& a) {
    unsigned char* ws = a.ws;
    LAS float* scr = (LAS float*)(F.lds + RING_OFF + F.wave * 16384);
    const int gw = F.vcu * NWAVES + F.wave, NGW = F.G * NWAVES;
    const int jm = a.jobmask;
    constexpr int NJ = 14;
    TrJob jobs[NJ] = {
        {(const float*)a.in[5], D_FF, D_MODEL, 0, D_FF, (bf16*)(ws + WS_WF1GU), 1, 0},
        {(const float*)a.in[6], D_FF, D_MODEL, 0, D_FF, (bf16*)(ws + WS_WF1GU), 1, 128},
        {(const float*)a.in[7], D_MODEL, D_FF, 0, D_MODEL, (bf16*)(ws + WS_WF1D), 0, 0},
        {(const float*)a.in[30], D_FF, D_MODEL, 0, D_FF, (bf16*)(ws + WS_WF2GU), 1, 0},
        {(const float*)a.in[31], D_FF, D_MODEL, 0, D_FF, (bf16*)(ws + WS_WF2GU), 1, 128},
        {(const float*)a.in[32], D_MODEL, D_FF, 0, D_MODEL, (bf16*)(ws + WS_WF2D), 0, 0},
        {(const float*)a.in[10], IN_W, D_MODEL, 0, 2560, (bf16*)(ws + WS_WIN), 0, 0},
        {(const float*)a.in[10], IN_W, D_MODEL, C_G, 24, (bf16*)(ws + WS_WIN), 0, 4608},
        {(const float*)a.in[10], IN_W, D_MODEL, C_ZX, 2048, (bf16*)(ws + WS_WIN), 0, 2560},
        {(const float*)a.in[27], D_MODEL, D_MODEL, 0, D_MODEL, (bf16*)(ws + WS_WOUT), 0, 0},
        {(const float*)a.in[35], D_MODEL, D_MODEL, 0, D_MODEL, (bf16*)(ws + WS_WPG), 0, 0},
        {(const float*)a.in[36], D_MODEL, PLE_DIM, 0, D_MODEL, (bf16*)(ws + WS_WPP), 0, 0},
        {(const float*)a.in[20], 128, 1024, 0, 128, (bf16*)(ws + WS_SMALL), 0, 0},
        {(const float*)a.in[22], 128, 1024, 0, 128, (bf16*)(ws + WS_SMALL + 256 * 1024), 0, 0},
    };
    const int jbit[NJ] = {JM_FF1, JM_FF1, JM_FF1, JM_FF2, JM_FF2, JM_FF2, JM_WIN, JM_WIN, JM_WIN, JM_OUT, JM_OUT, JM_OUT, JM_MIX, JM_MIX};
    int it = gw;
#pragma unroll
    for (int j = 0; j < NJ; ++j) {
        if (!(jm & jbit[j])) continue;
        const int n = trjob_items(jobs[j]);
        for (; it < n; it += NGW) trjob_run(jobs[j], it, scr, F.lane);
        it -= n;
    }
    if (jm & JM_WIN) {
        { GAS v4u* z = (GAS v4u*)(ws + WS_WIN + (size_t)4640 * D_MODEL * 2); const int n16 = (N_IN_PAD - 4640) * D_MODEL * 2 / 16;
          for (int i = gw * 64 + F.lane; i < n16; i += NGW * 64) z[i] = (v4u){0u, 0u, 0u, 0u}; }
        { float* tab = (float*)(ws + WS_TAB); const int* positions = (const int*)a.in[2];
          for (int i = gw * 64 + F.lane; i < MTOK * 16; i += NGW * 64) { const int row = i >> 4, k = i & 15;
              const float inv_freq = powf(500000.0f, -(float)k / 16.0f); const float ang = (float)positions[row] * inv_freq;
              float sn, cs; sincosf(ang, &sn, &cs); tab[row * 32 + k] = cs; tab[row * 32 + 16 + k] = sn; } }
    }
    if (jm & JM_MIX) p0_mix(F, a);
    if (jm & JM_OUT) {
        const GAS f32x4* src = (const GAS f32x4*)a.in[1]; GAS unsigned long long* dst = (GAS unsigned long long*)(ws + WS_P16);
        for (int i = gw * 64 + F.lane; i < MTOK * PLE_DIM / 4; i += NGW * 64) { const f32x4 v = src[i]; dst[i] = (unsigned long long)pk2(v.x, v.y) | ((unsigned long long)pk2(v.z, v.w) << 32); }
    }
    if (jm & JM_FF1)
        for (int m = gw; m < MTOK; m += NGW) rms_row_to_bf16((const float*)a.in[0] + (size_t)m * D_MODEL, (const float*)a.in[3], (bf16*)(ws + WS_U) + (size_t)m * D_MODEL, F.lane);
}

__device__ __forceinline__ void thin_phase(Frame& F, const float* hin, const float* y, const float* gpost, float scale, float* hout, const float* gpre, bf16* uout) {
    const int gw = F.vcu * NWAVES + F.wave, NGW = F.G * NWAVES, lane = F.lane;
    for (int m = gw; m < MTOK; m += NGW) {
        const GAS f32x4* yr = (const GAS f32x4*)(y + (size_t)m * D_MODEL) + lane; const GAS f32x4* hr = (const GAS f32x4*)(hin + (size_t)m * D_MODEL) + lane;
        const GAS f32x4* gp = (const GAS f32x4*)gpost + lane;
        f32x4 v[8], hv[8]; float s = 0.f;
#pragma unroll
        for (int j = 0; j < 8; ++j) { v[j] = yr[64 * j]; hv[j] = hr[64 * j]; s += (v[j].x * v[j].x + v[j].y * v[j].y) + (v[j].z * v[j].z + v[j].w * v[j].w); }
        const float r1 = scale / sqrtf(wave_sum_x(s) * (1.f / D_MODEL) + RMS_EPS);
        GAS f32x4* ho = (GAS f32x4*)(hout + (size_t)m * D_MODEL) + lane; float s2 = 0.f;
#pragma unroll
        for (int j = 0; j < 8; ++j) { const f32x4 g = gp[64 * j]; f32x4 h;
            h.x = hv[j].x + v[j].x * r1 * g.x; h.y = hv[j].y + v[j].y * r1 * g.y; h.z = hv[j].z + v[j].z * r1 * g.z; h.w = hv[j].w + v[j].w * r1 * g.w;
            ho[64 * j] = h; v[j] = h; s2 += (h.x * h.x + h.y * h.y) + (h.z * h.z + h.w * h.w); }
        if (uout) {
            const float r2 = 1.0f / sqrtf(wave_sum_x(s2) * (1.f / D_MODEL) + RMS_EPS);
            const GAS f32x4* gq = (const GAS f32x4*)gpre + lane; GAS unsigned long long* o8 = (GAS unsigned long long*)(uout + (size_t)m * D_MODEL) + lane;
#pragma unroll
            for (int j = 0; j < 8; ++j) { const f32x4 g = gq[64 * j];
                o8[64 * j] = (unsigned long long)pk2(v[j].x * r2 * g.x, v[j].y * r2 * g.y) | ((unsigned long long)pk2(v[j].z * r2 * g.z, v[j].w * r2 * g.w) << 32); }
        }
    }
}

struct EpiSwiGLU {
    static constexpr bool PERM = true, AFTER_DRAIN = false;
    bf16* O; int ldc;
    __device__ __forceinline__ void operator()(const pg8::f32x4 (&acc)[2][2][4][2], const pg8::Unit& u, int wr, int wc, int fr, int fq) const {
        const int row0 = u.pm * 256 + wr * 64 + fr, col0 = u.pn * 128 + wc * 32 + 8 * fq;
#pragma unroll
        for (int ai = 0; ai < 2; ++ai)
#pragma unroll
            for (int m = 0; m < 4; ++m) {
                bf16* rowp = O + (size_t)(row0 + ai * 128 + m * 16) * ldc + col0;
                float v[8];
#pragma unroll
                for (int n = 0; n < 2; ++n)
#pragma unroll
                    for (int j = 0; j < 4; ++j) { const float g = acc[ai][0][m][n][j], up = acc[ai][1][m][n][j]; v[4 * n + j] = g * __builtin_amdgcn_rcpf(1.f + __expf(-g)) * up; }
                v4u w; w.x = pg8::cvt_pk_bf16(v[0], v[1]); w.y = pg8::cvt_pk_bf16(v[2], v[3]); w.z = pg8::cvt_pk_bf16(v[4], v[5]); w.w = pg8::cvt_pk_bf16(v[6], v[7]);
                *(v4u*)rowp = w;
            }
    }
};
struct EpiF32 {
    static constexpr bool PERM = false, AFTER_DRAIN = false;
    float* O; int ldc;
    __device__ __forceinline__ void operator()(const pg8::f32x4 (&acc)[2][2][4][2], const pg8::Unit& u, int wr, int wc, int fr, int fq) const {
        const int row0 = u.pm * 256 + wr * 64 + fr, col0 = u.pn * 256 + wc * 32 + 4 * fq;
#pragma unroll
        for (int ai = 0; ai < 2; ++ai)
#pragma unroll
            for (int m = 0; m < 4; ++m) {
                float* rowp = O + (size_t)(row0 + ai * 128 + m * 16) * ldc + col0;
#pragma unroll
                for (int bj = 0; bj < 2; ++bj)
#pragma unroll
                    for (int n = 0; n < 2; ++n) *(pg8::f32x4*)(rowp + bj * 128 + n * 16) = acc[ai][bj][m][n];
            }
    }
};

struct EpiPle {
    static constexpr bool PERM = false, AFTER_DRAIN = false;
    float* O; int ldc;
    __device__ __forceinline__ void operator()(const pg8::f32x4 (&acc)[2][2][4][2], const pg8::Unit& u, int wr, int wc, int fr, int fq) const {
        const int row0 = u.pm * 256 + wr * 64 + fr, col0 = u.pn * 256 + wc * 32 + 4 * fq;
#pragma unroll
        for (int ai = 0; ai < 2; ++ai)
#pragma unroll
            for (int m = 0; m < 4; ++m) {
                float* rowp = O + (size_t)(row0 + ai * 128 + m * 16) * ldc + col0;
#pragma unroll
                for (int bj = 0; bj < 2; ++bj)
#pragma unroll
                    for (int n = 0; n < 2; ++n) { const pg8::f32x4 pp = *(const pg8::f32x4*)(rowp + bj * 128 + n * 16); const pg8::f32x4 a = acc[ai][bj][m][n]; pg8::f32x4 o;
#pragma unroll
                        for (int j = 0; j < 4; ++j) o[j] = pp[j] * __builtin_amdgcn_rcpf(1.f + __expf(-a[j]));
                        *(pg8::f32x4*)(rowp + bj * 128 + n * 16) = o; }
            }
    }
};
struct EpiWin {
    static constexpr bool PERM = false, AFTER_DRAIN = false;
    unsigned char* yz; const float* tab; const float* gate_b;
    __device__ __forceinline__ void operator()(const pg8::f32x4 (&acc)[2][2][4][2], const pg8::Unit& u, int wr, int wc, int fr, int fq) const {
        typedef unsigned u32x2 __attribute__((ext_vector_type(2)));
        const int pn = u.pn, row0 = u.pm * 256 + wr * 64 + fr;
        if (pn < 10) {
            const bool isq = pn < 4; const int kind = pn - 4;
            const bool rope = (wc == 0) && (isq || !(kind & 1));
#pragma unroll
            for (int ai = 0; ai < 2; ++ai)
#pragma unroll
                for (int m = 0; m < 4; ++m) {
                    const int row = row0 + ai * 128 + m * 16, b = row >> 12, t = row & (SEQ - 1);
                    pg8::f32x4 cs = {1.f, 1.f, 1.f, 1.f}, sn = {0.f, 0.f, 0.f, 0.f};
                    if (rope) { cs = *(const pg8::f32x4*)(tab + (size_t)row * 32 + 4 * fq); sn = *(const pg8::f32x4*)(tab + (size_t)row * 32 + 16 + 4 * fq); }
#pragma unroll
                    for (int bj = 0; bj < 2; ++bj) {
                        pg8::f32x4 v0 = acc[ai][bj][m][0], v1 = acc[ai][bj][m][1];
                        if (rope) { const pg8::f32x4 x1 = v0, x2 = v1; v0 = x1 * cs - x2 * sn; v1 = x2 * cs + x1 * sn; }
                        bf16* dst = isq ? (bf16*)(yz + YZ_Q) + (size_t)row * NSA_W + (2 * pn + bj) * HD
                                        : (bf16*)(yz + YZ_KV + (size_t)kind * 4 * MiB) + ((size_t)(b * KVH + bj) * SEQ + t) * HD;
                        dst += 32 * wc + 4 * fq;
                        u32x2 w0, w1; w0.x = pg8::cvt_pk_bf16(v0[0], v0[1]); w0.y = pg8::cvt_pk_bf16(v0[2], v0[3]); w1.x = pg8::cvt_pk_bf16(v1[0], v1[1]); w1.y = pg8::cvt_pk_bf16(v1[2], v1[3]);
                        *(u32x2*)dst = w0; *(u32x2*)(dst + 16) = w1;
                    }
                }
        } else if (pn < 18) {
            bf16* base = (bf16*)(yz + (pn < 14 ? YZ_ZX : YZ_ZY)) + 256 * ((pn - 10) & 3) + 32 * wc + 4 * fq;
#pragma unroll
            for (int ai = 0; ai < 2; ++ai)
#pragma unroll
                for (int m = 0; m < 4; ++m) {
                    bf16* rowp = base + (size_t)(row0 + ai * 128 + m * 16) * LRU_W;
#pragma unroll
                    for (int bj = 0; bj < 2; ++bj)
#pragma unroll
                        for (int n = 0; n < 2; ++n) { const pg8::f32x4 v = acc[ai][bj][m][n]; u32x2 w; w.x = pg8::cvt_pk_bf16(v[0], v[1]); w.y = pg8::cvt_pk_bf16(v[2], v[3]); *(u32x2*)(rowp + bj * 128 + n * 16) = w; }
                }
        } else {
            if (wc == 0) {
#pragma unroll
                for (int n = 0; n < 2; ++n) {
                    const int c0 = 16 * n + 4 * fq;
                    if (c0 < 24) {
                        const pg8::f32x4 gb = *(const pg8::f32x4*)(gate_b + c0);
#pragma unroll
                        for (int ai = 0; ai < 2; ++ai)
#pragma unroll
                            for (int m = 0; m < 4; ++m) { const int row = row0 + ai * 128 + m * 16; const pg8::f32x4 a = acc[ai][0][m][n]; pg8::f32x4 o;
#pragma unroll
                                for (int j = 0; j < 4; ++j) o[j] = __builtin_amdgcn_rcpf(1.f + __expf(-(a[j] + gb[j])));
                                *(pg8::f32x4*)((float*)(yz + YZ_GATES) + (size_t)row * 24 + c0) = o; }
                    }
                }
            }
        }
    }
};


typedef float f32x16 __attribute__((ext_vector_type(16)));
typedef unsigned u32x4 __attribute__((ext_vector_type(4)));
constexpr size_t SM_WAT = 0, SM_WIT = 256 * 1024, SM_W2F = 512 * 1024  , SM_BIASP = 768 * 1024  ;
constexpr size_t KC_OFF = 0, VC_OFF = 256 * 1024  , SUMA_OFF = 512 * 1024, SUMH_OFF = 1024 * 1024  ;
constexpr size_t WS_OATT = WS_WF1GU;
constexpr size_t SCAN_A = 0, SCAN_U = 32 * MiB;

__device__ __forceinline__ float gelu_tanh_f(float x) {
    const float k0 = 0.7978845608028654f, k1 = 0.044715f;
    return 0.5f * x * (1.f + tanhf(k0 * (x + k1 * x * x * x)));
}
__device__ __forceinline__ float bf2f_d(unsigned short v) { return __uint_as_float((unsigned)v << 16); }

__device__ __forceinline__ void p0_mix(Frame& F, const Args& a) {
    unsigned char* ws = a.ws;
    const int gw = F.vcu * NWAVES + F.wave, NGW = F.G * NWAVES, lane = F.lane;
    for (int type = 0; type < 2; ++type) {
        const float* w1 = (const float*)a.in[type ? 15 : 13]; GAS v4u* d1 = (GAS v4u*)(ws + (type ? WS_WCMPV : WS_WCMPK));
        for (int i = gw * 64 + lane; i < 256 * 512; i += NGW * 64) {
            const int n = i & 255, k8 = i >> 8; float v[8];
#pragma unroll
            for (int j = 0; j < 8; ++j) v[j] = w1[(size_t)(8 * k8 + j) * 256 + n];
            const int wv = n >> 5, nf = (n >> 4) & 1, col = n & 15, ks = k8 >> 2, kg = k8 & 3, ln = kg * 16 + col;
            d1[(size_t)((wv * 2 + nf) * 128 + ks) * 64 + ln] = (v4u){pk2(v[0], v[1]), pk2(v[2], v[3]), pk2(v[4], v[5]), pk2(v[6], v[7])};
        }
        const float* w2 = (const float*)a.in[type ? 16 : 14]; GAS v4u* d2 = (GAS v4u*)(ws + WS_SMALL + SM_W2F + type * 65536);
        for (int i = gw * 64 + lane; i < 128 * 32; i += NGW * 64) {
            const int n = i & 127, k8 = i >> 7; float v[8];
#pragma unroll
            for (int j = 0; j < 8; ++j) v[j] = w2[(size_t)(8 * k8 + j) * 128 + n];
            const int wv = n >> 4, col = n & 15, ks = k8 >> 2, kg = k8 & 3, ln = kg * 16 + col;
            d2[(size_t)(wv * 8 + ks) * 64 + ln] = (v4u){pk2(v[0], v[1]), pk2(v[2], v[3]), pk2(v[4], v[5]), pk2(v[6], v[7])};
        }
    }
    if (gw < 64) {
        const int type = gw >> 5, part = gw & 31;
        const float* w1 = (const float*)a.in[type ? 15 : 13]; const float* pos = (const float*)a.in[type ? 12 : 11];
        float acc[4] = {0.f, 0.f, 0.f, 0.f};
        for (int ii = 0; ii < 128; ++ii) { const int i = 128 * part + ii; const float pv = pos[i];
#pragma unroll
            for (int q = 0; q < 4; ++q) acc[q] += pv * w1[(size_t)i * 256 + lane + 64 * q]; }
        float* bp = (float*)(ws + WS_SMALL + SM_BIASP) + (size_t)(type * 32 + part) * 256;
#pragma unroll
        for (int q = 0; q < 4; ++q) bp[lane + 64 * q] = acc[q];
    }
}

__device__ __forceinline__ void compress_unit(Frame& F, const Args& a, int unit) {
    unsigned char* ws = a.ws; char* lds = (char*)(F.lds);
    const int type = unit >> 6, bg = (unit >> 4) & 3, ti = unit & 15;
    const int tid = F.tid, lane = F.lane, w = F.wave;
    const unsigned short* src = (const unsigned short*)(ws + WS_YZ + YZ_KV + (size_t)type * 4 * MiB) + ((size_t)bg * SEQ + 256 * ti) * HD;
    char* hid = lds + 72 * 1024; float* biasv = (float*)(lds + 72 * 1024 + 16 * 528);
    for (int i = tid; i < 272 * 16; i += NWAVES * 64) { const int tok = i >> 4, ch = i & 15;
        const u32x4 v = *(const u32x4*)(src + (size_t)tok * HD + ch * 8);
        *(u32x4*)(lds + tok * 256 + ((ch ^ ((tok >> 4) & 15)) << 4)) = v; }
    if (tid < 256) { const float* bp = (const float*)(ws + WS_SMALL + SM_BIASP) + (size_t)type * 32 * 256 + tid; float s = 0.f;
        for (int p = 0; p < 32; ++p) s += bp[p * 256];
        biasv[tid] = s; }
    __syncthreads();
    const int row = lane & 15, kg = lane >> 4;
    pg8::f32x4 acc0 = {0.f, 0.f, 0.f, 0.f}, acc1 = {0.f, 0.f, 0.f, 0.f};
    const pg8::bf16x8* Bf = (const pg8::bf16x8*)(ws + (type ? WS_WCMPV : WS_WCMPK)) + (size_t)(w * 2) * 128 * 64 + lane;
    pg8::bf16x8 bA[4][2], bB[4][2];
#define CMP_LOAD(dst, k0) do { _Pragma("unroll") for (int q = 0; q < 4; ++q) { dst[q][0] = Bf[(size_t)((k0) + q) * 64]; dst[q][1] = Bf[(size_t)(128 + (k0) + q) * 64]; } } while (0)
#define CMP_COMP(srcb, k0) do { _Pragma("unroll") for (int q = 0; q < 4; ++q) { const int ks = (k0) + q, tk = ks >> 2, chunk = 4 * (ks & 3) + kg, tok = 16 * row + tk; \
        const pg8::bf16x8 af = *(const pg8::bf16x8*)(lds + tok * 256 + ((chunk ^ ((tok >> 4) & 15)) << 4)); \
        acc0 = __builtin_amdgcn_mfma_f32_16x16x32_bf16(af, srcb[q][0], acc0, 0, 0, 0); acc1 = __builtin_amdgcn_mfma_f32_16x16x32_bf16(af, srcb[q][1], acc1, 0, 0, 0); } } while (0)
    CMP_LOAD(bA, 0);
    for (int k0 = 0; k0 < 128; k0 += 8) {
        CMP_LOAD(bB, k0 + 4);
        CMP_COMP(bA, k0);
        if (k0 + 8 < 128) CMP_LOAD(bA, k0 + 8);
        CMP_COMP(bB, k0 + 4);
    }
#undef CMP_LOAD
#undef CMP_COMP
    {
        const int n0 = 32 * w + (lane & 15);
#pragma unroll
        for (int reg = 0; reg < 4; ++reg) { const int c = 4 * kg + reg;
            *(unsigned short*)(hid + c * 528 + n0 * 2) = (unsigned short)f2bf(gelu_tanh_f(acc0[reg] + biasv[n0]));
            *(unsigned short*)(hid + c * 528 + (n0 + 16) * 2) = (unsigned short)f2bf(gelu_tanh_f(acc1[reg] + biasv[n0 + 16])); }
    }
    __syncthreads();
    {
        pg8::f32x4 acc2 = {0.f, 0.f, 0.f, 0.f};
        const pg8::bf16x8* B2 = (const pg8::bf16x8*)(ws + WS_SMALL + SM_W2F + type * 65536) + (size_t)(w * 8) * 64 + lane;
#pragma unroll
        for (int ks = 0; ks < 8; ++ks) { const pg8::bf16x8 af = *(const pg8::bf16x8*)(hid + row * 528 + (32 * ks + 8 * kg) * 2);
            acc2 = __builtin_amdgcn_mfma_f32_16x16x32_bf16(af, B2[(size_t)ks * 64], acc2, 0, 0, 0); }
        unsigned short* dst = (unsigned short*)(ws + WS_KCVC + (type ? VC_OFF : KC_OFF)) + ((size_t)bg * 256 + 16 * ti) * HD + 16 * w + (lane & 15);
#pragma unroll
        for (int reg = 0; reg < 4; ++reg) { const int c = 4 * kg + reg; dst[(size_t)c * HD] = (16 * ti + c == N_CMP) ? (unsigned short)0 : (unsigned short)f2bf(acc2[reg]); }
    }
    __syncthreads();
}

constexpr int XC_PITCH = 2064;
__device__ __forceinline__ void rglru_local_unit(Frame& F, const Args& a, int unit) {
    unsigned char* ws = a.ws; char* lds = (char*)(F.lds);
    const int b = unit >> 6, ch = unit & 63, t0 = ch * 64; const size_t row0 = (size_t)b * SEQ + t0;
    const int tid = F.tid, lane = F.lane, h = F.wave, r32 = lane & 31, hi = lane >> 5;
    {
        const int cgp = tid & 127, tq = tid >> 7;
        const unsigned short* zx = (const unsigned short*)(ws + WS_YZ + YZ_ZX);
        const float* cw = (const float*)a.in[18]; const float* cb = (const float*)a.in[19];
        float wv[4][8], bb[8];
#pragma unroll
        for (int wi = 0; wi < 4; ++wi) { const f32x4 x0 = *(const f32x4*)(cw + wi * LRU_W + 8 * cgp), x1 = *(const f32x4*)(cw + wi * LRU_W + 8 * cgp + 4);
            wv[wi][0] = x0.x; wv[wi][1] = x0.y; wv[wi][2] = x0.z; wv[wi][3] = x0.w; wv[wi][4] = x1.x; wv[wi][5] = x1.y; wv[wi][6] = x1.z; wv[wi][7] = x1.w; }
        { const f32x4 x0 = *(const f32x4*)(cb + 8 * cgp), x1 = *(const f32x4*)(cb + 8 * cgp + 4); bb[0] = x0.x; bb[1] = x0.y; bb[2] = x0.z; bb[3] = x0.w; bb[4] = x1.x; bb[5] = x1.y; bb[6] = x1.z; bb[7] = x1.w; }
        for (int tt = 0; tt < 16; ++tt) {
            const int tok = 16 * tq + tt; float o[8];
#pragma unroll
            for (int e = 0; e < 8; ++e) o[e] = bb[e];
#pragma unroll
            for (int wi = 0; wi < 4; ++wi) { const int tsrc = t0 + tok - 3 + wi;
                if (tsrc >= 0) { const u32x4 xv = *(const u32x4*)(zx + (row0 + tok - 3 + wi) * LRU_W + 8 * cgp);
#pragma unroll
                    for (int e = 0; e < 4; ++e) { const unsigned wd = xv[e]; o[2 * e] += wv[wi][2 * e] * __uint_as_float(wd << 16); o[2 * e + 1] += wv[wi][2 * e + 1] * __uint_as_float(wd & 0xffff0000u); } } }
            *(u32x4*)(lds + tok * XC_PITCH + cgp * 16) = (u32x4){pk2(o[0], o[1]), pk2(o[2], o[3]), pk2(o[4], o[5]), pk2(o[6], o[7])};
        }
    }
    __syncthreads();
    const unsigned short* WaT = (const unsigned short*)(ws + WS_SMALL + SM_WAT); const unsigned short* WiT = (const unsigned short*)(ws + WS_SMALL + SM_WIT);
    float* Ag = (float*)(ws + WS_ACT + SCAN_A); float* Ug = (float*)(ws + WS_ACT + SCAN_U);
#pragma unroll 1
    for (int nc = 0; nc < 4; ++nc) {
        const int c = 128 * h + 32 * nc + r32;
        pg8::bf16x8 bfa[8], bfi[8];
#pragma unroll
        for (int ks = 0; ks < 8; ++ks) { bfa[ks] = *(const pg8::bf16x8*)(WaT + (size_t)(32 * nc + r32) * 1024 + 128 * h + 16 * ks + 8 * hi);
                                         bfi[ks] = *(const pg8::bf16x8*)(WiT + (size_t)(32 * nc + r32) * 1024 + 128 * h + 16 * ks + 8 * hi); }
        const float ba = ((const float*)a.in[21])[c], bi = ((const float*)a.in[23])[c];
        const float nl = -((const float*)a.in[24])[c]; const float sp = (nl > 20.f) ? nl : log1pf(expf(nl));
        float SA = 1.f, SH = 0.f;
#pragma unroll 1
        for (int mf = 0; mf < 2; ++mf) {
            f32x16 acc_a = {}, acc_i = {};
#pragma unroll
            for (int ks = 0; ks < 8; ++ks) { const pg8::bf16x8 af = *(const pg8::bf16x8*)(lds + (32 * mf + r32) * XC_PITCH + (128 * h + 16 * ks + 8 * hi) * 2);
                acc_a = __builtin_amdgcn_mfma_f32_32x32x16_bf16(af, bfa[ks], acc_a, 0, 0, 0); acc_i = __builtin_amdgcn_mfma_f32_32x32x16_bf16(af, bfi[ks], acc_i, 0, 0, 0); }
            float GA[4], GH[4];
#pragma unroll
            for (int k = 0; k < 4; ++k) { GA[k] = 1.f; GH[k] = 0.f;
#pragma unroll
                for (int q = 0; q < 4; ++q) { const int r = 4 * k + q, tok = 32 * mf + 8 * k + 4 * hi + q;
                    const float xv = bf2f_d(*(const unsigned short*)(lds + tok * XC_PITCH + c * 2));
                    const float rr = __builtin_amdgcn_rcpf(1.f + __expf(-(acc_a[r] + ba))), ig = __builtin_amdgcn_rcpf(1.f + __expf(-(acc_i[r] + bi)));
                    const float la = -8.0f * rr * sp, av = __expf(la), uv = __builtin_amdgcn_sqrtf(fmaxf(1.f - av * av, 0.f)) * (ig * xv);
                    Ag[(row0 + tok) * LRU_W + c] = av; Ug[(row0 + tok) * LRU_W + c] = uv;
                    GA[k] *= av; GH[k] = av * GH[k] + uv; } }
#pragma unroll
            for (int k = 0; k < 4; ++k) { const float oa = __shfl_xor(GA[k], 32), oh = __shfl_xor(GH[k], 32);
                const float a1 = hi ? oa : GA[k], h1 = hi ? oh : GH[k], a2 = hi ? GA[k] : oa, h2 = hi ? GH[k] : oh;
                SH = a1 * SH + h1; SA *= a1; SH = a2 * SH + h2; SA *= a2; }
        }
        if (hi == 0) { ((float*)(ws + WS_KCVC + SUMA_OFF))[(size_t)(b * 64 + ch) * LRU_W + c] = SA; ((float*)(ws + WS_KCVC + SUMH_OFF))[(size_t)(b * 64 + ch) * LRU_W + c] = SH; }
    }
    __syncthreads();
}

__device__ __forceinline__ void rglru_final_unit(Frame& F, const Args& a, int unit) {
    unsigned char* ws = a.ws; float* red = (float*)(F.lds);
    const int b = unit >> 6, ch = unit & 63; const size_t row0 = (size_t)b * SEQ + ch * 64;
    const int tid = F.tid, c = 2 * tid, w = F.wave;
    typedef float f32x2 __attribute__((ext_vector_type(2)));
    const float* SA = (const float*)(ws + WS_KCVC + SUMA_OFF) + (size_t)b * 64 * LRU_W + c; const float* SH = (const float*)(ws + WS_KCVC + SUMH_OFF) + (size_t)b * 64 * LRU_W + c;
    f32x2 hst = {0.f, 0.f};
    for (int j = 0; j < ch; ++j) { const f32x2 A = *(const f32x2*)(SA + (size_t)j * LRU_W), H = *(const f32x2*)(SH + (size_t)j * LRU_W); hst = A * hst + H; }
    const float* Ag = (const float*)(ws + WS_ACT + SCAN_A) + row0 * LRU_W + c; float* Ug = (float*)(ws + WS_ACT + SCAN_U) + row0 * LRU_W + c;
    const unsigned* zy = (const unsigned*)(ws + WS_YZ + YZ_ZY) + (row0 * LRU_W + c) / 2;
    for (int tok = 0; tok < 64; ++tok) {
        const f32x2 av = *(const f32x2*)(Ag + (size_t)tok * LRU_W), uv = *(const f32x2*)(Ug + (size_t)tok * LRU_W); const unsigned yv = zy[(size_t)tok * (LRU_W / 2)];
        hst = av * hst + uv;
        f32x2 o; o.x = hst.x * gelu_tanh_f(__uint_as_float(yv << 16)); o.y = hst.y * gelu_tanh_f(__uint_as_float(yv & 0xffff0000u));
        *(f32x2*)(Ug + (size_t)tok * LRU_W) = o;
        const float s = wave_sum_x(o.x * o.x + o.y * o.y);
        if (F.lane == 0) red[tok * 8 + w] = s;
    }
    __syncthreads();
    const f32x2 g = *(const f32x2*)((const float*)a.in[26] + c);
    unsigned* oc = (unsigned*)(ws + WS_U) + (row0 * D_MODEL + NSA_W + c) / 2;
    for (int tok = 0; tok < 64; ++tok) {
        float tot = 0.f;
#pragma unroll
        for (int q = 0; q < 8; ++q) tot += red[tok * 8 + q];
        const float r = 1.0f / sqrtf(tot * (1.f / LRU_W) + RMS_EPS);
        const f32x2 o = *(const f32x2*)(Ug + (size_t)tok * LRU_W);
        oc[(size_t)tok * (D_MODEL / 2)] = pk2(o.x * r * g.x, o.y * r * g.y);
    }
    __syncthreads();
}

__device__ __forceinline__ void oattn_norm_phase(Frame& F, const Args& a) {
    unsigned char* ws = a.ws;
    const int gw = F.vcu * NWAVES + F.wave, NGW = F.G * NWAVES, lane = F.lane;
    const GAS f32x4* gp = (const GAS f32x4*)a.in[25] + lane;
    for (int m = gw; m < MTOK; m += NGW) {
        const GAS f32x4* xr = (const GAS f32x4*)((const float*)(ws + WS_OATT) + (size_t)m * NSA_W) + lane;
        f32x4 v[4]; float s = 0.f;
#pragma unroll
        for (int j = 0; j < 4; ++j) { v[j] = xr[64 * j]; s += (v[j].x * v[j].x + v[j].y * v[j].y) + (v[j].z * v[j].z + v[j].w * v[j].w); }
        const float r = 1.0f / sqrtf(wave_sum_x(s) * (1.f / NSA_W) + RMS_EPS);
        GAS unsigned long long* o8 = (GAS unsigned long long*)((bf16*)(ws + WS_U) + (size_t)m * D_MODEL) + lane;
#pragma unroll
        for (int j = 0; j < 4; ++j) { const f32x4 g = gp[64 * j];
            o8[64 * j] = (unsigned long long)pk2(v[j].x * r * g.x, v[j].y * r * g.y) | ((unsigned long long)pk2(v[j].z * r * g.z, v[j].w * r * g.w) << 32); }
    }
}
namespace att {
typedef short bf16x8 __attribute__((ext_vector_type(8)));
typedef short s16x4 __attribute__((ext_vector_type(4)));
typedef float f32x16 __attribute__((ext_vector_type(16)));
typedef float f32x4 __attribute__((ext_vector_type(4)));
typedef unsigned u32x4 __attribute__((ext_vector_type(4)));
constexpr float SCALE = 0.08838834764831845f, THR = 8.f;
constexpr int SHM_K = 16384, SHM_V = 16384;
#define KSWZ(row, colB) ((row) * 256 + ((colB) ^ (((row) & 7) << 4)))
#define SBAR() __builtin_amdgcn_sched_barrier(0)
__device__ __forceinline__ int v_st(int k, int c) { const int kk = (k & ~0xC) | ((k & 4) << 1) | ((k & 8) >> 1); return ((kk >> 3) * 4 + (c >> 5)) * 512 + ((kk & 7) * 32 + (c & 31)) * 2; }
__device__ __forceinline__ int v_rd_base(int lane) { return ((lane & 3) << 3) | (((lane >> 2) & 3) << 6) | (((lane >> 4) & 1) << 5) | (((lane >> 5) & 1) << 8); }
constexpr int v_rd_off(int d0, int ks, int half) { return d0 * 512 + ks * 4096 + half * 2048; }
__device__ __forceinline__ int crow(int r, int hi) { return (r & 3) + 8 * (r >> 2) + 4 * hi; }
__device__ __forceinline__ unsigned cvtpk(float lo, float hi) {
    unsigned r; asm volatile("v_cvt_pk_bf16_f32 %0, %1, %2" : "=v"(r) : "v"(lo), "v"(hi)); return r;
}
__device__ __forceinline__ void mask_tile(f32x16& p0, f32x16& p1, int dq, unsigned W) {
    const float NEG = -__builtin_inff();
#pragma unroll
    for (int r = 0; r < 16; ++r) {
        const int c = (r & 3) + 8 * (r >> 2);
        if ((unsigned)(dq - c) >= W) p0[r] = NEG;
        if ((unsigned)(dq - c - 32) >= W) p1[r] = NEG;
    }
}
__device__ __forceinline__ void partialSM(f32x16& p0, f32x16& p1, float& m_reg, float& mn, float& alpha) {
    float pmax = p0[0]; for (int r = 1; r < 16; ++r) pmax = fmaxf(pmax, p0[r]); for (int r = 0; r < 16; ++r) pmax = fmaxf(pmax, p1[r]);
    { auto rr = __builtin_amdgcn_permlane32_swap(__float_as_uint(pmax), __float_as_uint(pmax), false, false);
      pmax = fmaxf(__uint_as_float(rr[0]), __uint_as_float(rr[1])); }
    constexpr float C2 = 1.4426950408889634f * SCALE;
    if (__builtin_expect(__all((pmax - m_reg) * SCALE <= THR), 1)) { mn = m_reg; alpha = 1.f; }
    else { mn = fmaxf(m_reg, pmax); alpha = __builtin_amdgcn_exp2f((m_reg - mn) * C2); m_reg = mn; }
    const float mnL = -mn * C2;
    for (int r = 0; r < 16; ++r) p0[r] = fmaf(p0[r], C2, mnL); for (int r = 0; r < 16; ++r) p1[r] = fmaf(p1[r], C2, mnL);
    for (int r = 0; r < 16; ++r) p0[r] = __builtin_amdgcn_exp2f(p0[r]);
}
__device__ __forceinline__ void finishSM(f32x16& p0, f32x16& p1, float alpha, float& l_reg, bf16x8& pa0, bf16x8& pa1, bf16x8& pa2, bf16x8& pa3) {
    for (int r = 0; r < 16; ++r) p1[r] = __builtin_amdgcn_exp2f(p1[r]);
    float ps = 0; for (int r = 0; r < 16; ++r) ps += p0[r]; for (int r = 0; r < 16; ++r) ps += p1[r];
    { auto rr = __builtin_amdgcn_permlane32_swap(__float_as_uint(ps), __float_as_uint(ps), false, false);
      ps = __uint_as_float(rr[0]) + __uint_as_float(rr[1]); }
    l_reg = l_reg * alpha + ps;
#define PK4(P, B_, OUT) do { unsigned a0 = cvtpk(P[B_+0], P[B_+1]), a1 = cvtpk(P[B_+2], P[B_+3]);                          \
        unsigned b0 = cvtpk(P[B_+4], P[B_+5]), b1 = cvtpk(P[B_+6], P[B_+7]);                                             \
        auto r0 = __builtin_amdgcn_permlane32_swap(a0, b0, false, false); auto r1 = __builtin_amdgcn_permlane32_swap(a1, b1, false, false); \
        u32x4 w = {r0[0], r1[0], r0[1], r1[1]}; OUT = *reinterpret_cast<bf16x8*>(&w); } while (0)
    PK4(p0, 0, pa0); PK4(p0, 8, pa1); PK4(p1, 0, pa2); PK4(p1, 8, pa3);
#undef PK4
}
template <int KB, bool SK>
__device__ __forceinline__ void qkt(f32x16& p0, f32x16& p1, const char* K_lds, int r32, int hi, const bf16x8* qr, bool act) {
    if (SK && !act) { const float NEG = -__builtin_inff();
#pragma unroll
        for (int r = 0; r < 16; ++r) { p0[r] = NEG; p1[r] = NEG; } return; }
    p0 = f32x16{}; p1 = f32x16{};
    const char* kb[4];
#pragma unroll
    for (int dd = 0; dd < 4; ++dd) kb[dd] = K_lds + KB * SHM_K + KSWZ(r32, (dd * 16 + hi * 8) * 2);
#pragma unroll
    for (int d0 = 0; d0 < 8; ++d0) { const char* a = kb[d0 & 3] + (d0 >> 2) * 128;
        bf16x8 b0 = *reinterpret_cast<const bf16x8*>(a);
        bf16x8 b1 = *reinterpret_cast<const bf16x8*>(a + 32 * 256);
        p0 = __builtin_amdgcn_mfma_f32_32x32x16_bf16(b0, qr[d0], p0, 0, 0, 0);
        p1 = __builtin_amdgcn_mfma_f32_32x32x16_bf16(b1, qr[d0], p1, 0, 0, 0); }
}
template <int VB, bool SK>
__device__ __forceinline__ void pv_tile(f32x16* o, int vb0, bf16x8 pa0, bf16x8 pa1, bf16x8 pa2, bf16x8 pa3, bool act) {
    if (SK && !act) return;
#define TRRD(dst, off) asm volatile("ds_read_b64_tr_b16 %0, %1 offset:%2" : "=&v"(dst) : "v"(vb0), "i"(off) : "memory")
#define PV_D0(d0) do { s16x4 l0, l1, l2, l3, h0, h1, h2, h3; constexpr int b_ = VB * SHM_V + v_rd_off(d0, 0, 0);     \
        TRRD(l0, b_); TRRD(h0, b_ + 2048); TRRD(l1, b_ + 4096); TRRD(h1, b_ + 6144); TRRD(l2, b_ + 8192); TRRD(h2, b_ + 10240); TRRD(l3, b_ + 12288); TRRD(h3, b_ + 14336); \
        asm volatile("s_waitcnt lgkmcnt(0)" ::: "memory"); SBAR();                 \
        o[d0] = __builtin_amdgcn_mfma_f32_32x32x16_bf16(pa0, (bf16x8){l0[0], l0[1], l0[2], l0[3], h0[0], h0[1], h0[2], h0[3]}, o[d0], 0, 0, 0);   \
        o[d0] = __builtin_amdgcn_mfma_f32_32x32x16_bf16(pa1, (bf16x8){l1[0], l1[1], l1[2], l1[3], h1[0], h1[1], h1[2], h1[3]}, o[d0], 0, 0, 0);   \
        o[d0] = __builtin_amdgcn_mfma_f32_32x32x16_bf16(pa2, (bf16x8){l2[0], l2[1], l2[2], l2[3], h2[0], h2[1], h2[2], h2[3]}, o[d0], 0, 0, 0);   \
        o[d0] = __builtin_amdgcn_mfma_f32_32x32x16_bf16(pa3, (bf16x8){l3[0], l3[1], l3[2], l3[3], h3[0], h3[1], h3[2], h3[3]}, o[d0], 0, 0, 0); } while (0)
    PV_D0(0); PV_D0(1); PV_D0(2); PV_D0(3);
#undef PV_D0
#undef TRRD
}


constexpr int AL_V = 0, AL_K = 16384, AL_WS = 32768, AL_IMP = 34816, AL_MASK = 51200;
#define ATT_STG_LOAD(Kp, Vp, key0, DOV) do { st_k0 = *(const bf16x8*)((Kp) + (size_t)((key0) + sr) * HD + sc); st_k1 = *(const bf16x8*)((Kp) + (size_t)((key0) + 32 + sr) * HD + sc); \
        if (DOV) { st_v0 = *(const bf16x8*)((Vp) + (size_t)((key0) + sr) * HD + sc); st_v1 = *(const bf16x8*)((Vp) + (size_t)((key0) + 32 + sr) * HD + sc); } } while (0)
#define ATT_STG_WRITE(DOV) do { *(bf16x8*)(K_lds + kws) = st_k0; *(bf16x8*)(K_lds + kws + 32 * 256) = st_k1; \
        if (DOV) { *(bf16x8*)(V_lds + vst0) = st_v0; *(bf16x8*)(V_lds + vst1) = st_v1; } } while (0)
#define ATT_RESC(al) do { if (__any((al) < 1.f)) { if (hi == 0) al_l[r32] = (al); asm volatile("s_waitcnt lgkmcnt(0)" ::: "memory"); \
        _Pragma("unroll") for (int d_ = 0; d_ < 4; ++d_) _Pragma("unroll") for (int r = 0; r < 16; ++r) o[d_][r] *= al_l[crow(r, hi)]; } } while (0)
#define ATT_PK4(P, B_, OUT) do { unsigned a0 = cvtpk(P[B_+0], P[B_+1]), a1 = cvtpk(P[B_+2], P[B_+3]); unsigned b0 = cvtpk(P[B_+4], P[B_+5]), b1 = cvtpk(P[B_+6], P[B_+7]); \
        auto r0 = __builtin_amdgcn_permlane32_swap(a0, b0, false, false); auto r1 = __builtin_amdgcn_permlane32_swap(a1, b1, false, false); \
        u32x4 w_ = {r0[0], r1[0], r0[1], r1[1]}; OUT = *reinterpret_cast<bf16x8*>(&w_); } while (0)

__device__ __forceinline__ void attn_unit(Frame& F, const Args& a, int unit) {
    unsigned char* ws = a.ws; char* lds = (char*)(F.lds);
    const int i = unit >> 2, b = (unit >> 1) & 1, g = unit & 1, t0 = 64 * i;
    const int tid = F.tid, wid = F.wave, lane = F.lane, r32 = lane & 31, hi = lane >> 5;
    const int hr = wid & 3, th = wid >> 2, h = 4 * g + hr, tw0 = t0 + 32 * th, trow = tw0 + r32;
    const size_t row0w = (size_t)b * SEQ + tw0;
    char* V_lds = lds + AL_V; char* K_lds = lds + AL_K;
    float* wscr = (float*)(lds + AL_WS) + wid * 64; float* li_l = wscr; float* al_l = wscr + 32;
    LAS unsigned* IMP = (LAS unsigned*)(F.lds + AL_IMP); unsigned char* MASKB = (unsigned char*)(lds + AL_MASK);
    const unsigned short* Qg = (const unsigned short*)(ws + WS_YZ + YZ_Q) + (row0w + r32) * NSA_W + h * HD;
    const unsigned short* KVg = (const unsigned short*)(ws + WS_YZ + YZ_KV) + (size_t)(b * KVH + g) * SEQ * HD;
    const unsigned short* KCg = (const unsigned short*)(ws + WS_KCVC + KC_OFF) + (size_t)(b * KVH + g) * 256 * HD;
    const unsigned short* VCg = (const unsigned short*)(ws + WS_KCVC + VC_OFF) + (size_t)(b * KVH + g) * 256 * HD;
    const float* GT = (const float*)(ws + WS_YZ + YZ_GATES) + (row0w + r32) * 24 + h * 3;
    float* OA = (float*)(ws + WS_OATT) + row0w * NSA_W + h * HD + r32;
    bf16x8 qr[8];
#pragma unroll
    for (int d0 = 0; d0 < 8; ++d0) qr[d0] = *(const bf16x8*)(Qg + d0 * 16 + hi * 8);
    for (int u = tid; u < 2 * 64 * 32; u += NWAVES * 64) IMP[u] = 0u;
    const int sr = tid >> 4, sc = (tid & 15) * 8, vst0 = v_st(sr, sc), vst1 = v_st(32 + sr, sc), kws = KSWZ(sr, sc * 2);
    const int vb0 = (int)(uintptr_t)V_lds + v_rd_base(lane);
    bf16x8 st_k0, st_k1, st_v0, st_v1;
    constexpr float C2 = 1.4426950408889634f * SCALE;
    f32x16 p0, p1, o[4]; bf16x8 pa0, pa1, pa2, pa3;
    {
        const int NTc = (4 * i + 2) / 64 + 1;
        const int qm = ((trow - 31) >> 4) - 4 * hi;
        float m = -1e30f, l = 0.f;
        for (int j = 0; j < NTc; ++j) {
            ATT_STG_LOAD(KCg, VCg, 64 * j, false);
            __syncthreads(); ATT_STG_WRITE(false); __syncthreads();
            qkt<0, false>(p0, p1, K_lds, r32, hi, qr, true);
            mask_tile(p0, p1, qm - 64 * j, 0x7fffffffu);
            float pmax = p0[0];
#pragma unroll
            for (int r = 1; r < 16; ++r) pmax = fmaxf(pmax, p0[r]);
#pragma unroll
            for (int r = 0; r < 16; ++r) pmax = fmaxf(pmax, p1[r]);
            { auto rr = __builtin_amdgcn_permlane32_swap(__float_as_uint(pmax), __float_as_uint(pmax), false, false); pmax = fmaxf(__uint_as_float(rr[0]), __uint_as_float(rr[1])); }
            const float mn = fmaxf(m, pmax), mnL = -mn * C2; float ps = 0.f;
#pragma unroll
            for (int r = 0; r < 16; ++r) ps += __builtin_amdgcn_exp2f(fmaf(p0[r], C2, mnL)) + __builtin_amdgcn_exp2f(fmaf(p1[r], C2, mnL));
            { auto rr = __builtin_amdgcn_permlane32_swap(__float_as_uint(ps), __float_as_uint(ps), false, false); ps = __uint_as_float(rr[0]) + __uint_as_float(rr[1]); }
            l = l * __builtin_amdgcn_exp2f((m - mn) * C2) + ps; m = mn;
        }
        const float inv = l > 0.f ? 1.0f / l : 0.f, mL = -m * C2;
#pragma unroll
        for (int d = 0; d < 4; ++d) o[d] = f32x16{};
        for (int j = 0; j < NTc; ++j) {
            ATT_STG_LOAD(KCg, VCg, 64 * j, true);
            __syncthreads(); ATT_STG_WRITE(true); __syncthreads();
            qkt<0, false>(p0, p1, K_lds, r32, hi, qr, true);
            mask_tile(p0, p1, qm - 64 * j, 0x7fffffffu);
#pragma unroll
            for (int r = 0; r < 16; ++r) { p0[r] = __builtin_amdgcn_exp2f(fmaf(p0[r], C2, mL)) * inv; p1[r] = __builtin_amdgcn_exp2f(fmaf(p1[r], C2, mL)) * inv; }
#pragma unroll
            for (int k = 0; k < 4; ++k) {
                const int s1 = 16 * j + 2 * k + hi;
                const unsigned q0 = (unsigned)(p0[4 * k] * 134217728.f + 0.5f), q1 = (unsigned)(p0[4 * k + 1] * 134217728.f + 0.5f), q2 = (unsigned)(p0[4 * k + 2] * 134217728.f + 0.5f), q3 = (unsigned)(p0[4 * k + 3] * 134217728.f + 0.5f);
                const unsigned e0 = (unsigned)(p1[4 * k] * 134217728.f + 0.5f), e1 = (unsigned)(p1[4 * k + 1] * 134217728.f + 0.5f), e2 = (unsigned)(p1[4 * k + 2] * 134217728.f + 0.5f), e3 = (unsigned)(p1[4 * k + 3] * 134217728.f + 0.5f);
                __hip_atomic_fetch_add(IMP + (th * 64 + s1) * 32 + r32, q0 + q1 + q2 + q3, __ATOMIC_RELAXED, __HIP_MEMORY_SCOPE_WORKGROUP);
                __hip_atomic_fetch_add(IMP + (th * 64 + s1 + 1) * 32 + r32, q3, __ATOMIC_RELAXED, __HIP_MEMORY_SCOPE_WORKGROUP);
                __hip_atomic_fetch_add(IMP + (th * 64 + s1 + 8) * 32 + r32, e0 + e1 + e2 + e3, __ATOMIC_RELAXED, __HIP_MEMORY_SCOPE_WORKGROUP);
                if (s1 + 9 < 64) __hip_atomic_fetch_add(IMP + (th * 64 + s1 + 9) * 32 + r32, e3, __ATOMIC_RELAXED, __HIP_MEMORY_SCOPE_WORKGROUP);
            }
            ATT_PK4(p0, 0, pa0); ATT_PK4(p0, 8, pa1); ATT_PK4(p1, 0, pa2); ATT_PK4(p1, 8, pa3);
            SBAR();
            pv_tile<0, false>(o, vb0, pa0, pa1, pa2, pa3, true);
        }
        if (hi == 0) li_l[r32] = GT[0];
        asm volatile("s_waitcnt lgkmcnt(0)" ::: "memory");
        { int hi_o = hi; float* OAp = OA; asm volatile("" : "+v"(hi_o), "+v"(OAp));
#pragma unroll
        for (int r = 0; r < 16; ++r) { const int orow = crow(r, hi_o); const float f = li_l[orow];
#pragma unroll
            for (int d0 = 0; d0 < 4; ++d0) OAp[(size_t)orow * NSA_W + d0 * 32] = o[d0][r] * f; } }
    }
    __syncthreads();
    {
        const int pair = tid >> 3, sg = tid & 7, thp = pair >> 5, qp = pair & 31;
        unsigned mine[8];
#pragma unroll
        for (int e = 0; e < 8; ++e) { const int s = sg * 8 + e; mine[e] = (s == i || s == 0) ? 0xFFFFFFFFu : (s < i ? IMP[(thp * 64 + s) * 32 + qp] + 1u : 0u); }
        int rank[8] = {0, 0, 0, 0, 0, 0, 0, 0};
        for (int s2 = 0; s2 < 64; ++s2) {
            const unsigned v2 = (s2 == i || s2 == 0) ? 0xFFFFFFFFu : (s2 < i ? IMP[(thp * 64 + s2) * 32 + qp] + 1u : 0u);
#pragma unroll
            for (int e = 0; e < 8; ++e) { const int s = sg * 8 + e; rank[e] += (v2 > mine[e] || (v2 == mine[e] && s2 < s)) ? 1 : 0; }
        }
        unsigned byte = 0;
#pragma unroll
        for (int e = 0; e < 8; ++e) byte |= (rank[e] < TOPK ? 1u : 0u) << e;
        MASKB[pair * 8 + sg] = (unsigned char)byte;
    }
    __syncthreads();
    const unsigned mlo = *(const unsigned*)(MASKB + (th * 32 + r32) * 8), mhi = *(const unsigned*)(MASKB + (th * 32 + r32) * 8 + 4);
    const float NEGINF = -__builtin_inff();
    {
        const unsigned short* Kg = KVg + (size_t)2 * (2 * MiB); const unsigned short* Vg = KVg + (size_t)3 * (2 * MiB);
        const int NT = i + 1, qm = trow - 4 * hi;
        float m_reg = -1e30f, l_reg = 0.f, mn, al;
#pragma unroll
        for (int d = 0; d < 4; ++d) o[d] = f32x16{};
        ATT_STG_LOAD(Kg, Vg, 0, true);
        for (int t = 0; t < NT; ++t) {
            __syncthreads(); ATT_STG_WRITE(true); __syncthreads();
            if (t + 1 < NT) ATT_STG_LOAD(Kg, Vg, 64 * (t + 1), true);
            const bool rowsel = (((t < 32) ? (mlo >> t) : (mhi >> (t - 32))) & 1u) != 0u;
            const bool act = __any(rowsel);
            qkt<0, true>(p0, p1, K_lds, r32, hi, qr, act);
            if (act) {
                if (!rowsel) {
#pragma unroll
                    for (int r = 0; r < 16; ++r) { p0[r] = NEGINF; p1[r] = NEGINF; } }
                if (t == NT - 1) mask_tile(p0, p1, qm - 64 * t, 0x7fffffffu);
            }
            partialSM(p0, p1, m_reg, mn, al);
            finishSM(p0, p1, al, l_reg, pa0, pa1, pa2, pa3); SBAR();
            ATT_RESC(al);
            pv_tile<0, true>(o, vb0, pa0, pa1, pa2, pa3, act);
        }
        if (hi == 0) li_l[r32] = GT[1] / l_reg;
        asm volatile("s_waitcnt lgkmcnt(0)" ::: "memory");
        { int hi_o = hi; float* OAp = OA; asm volatile("" : "+v"(hi_o), "+v"(OAp));
#pragma unroll
        for (int r = 0; r < 16; ++r) { const int orow = crow(r, hi_o); const float f = li_l[orow];
#pragma unroll
            for (int d0 = 0; d0 < 4; ++d0) { float* pp_ = OAp + (size_t)orow * NSA_W + d0 * 32; *pp_ = __hip_atomic_load(pp_, __ATOMIC_RELAXED, __HIP_MEMORY_SCOPE_AGENT) + o[d0][r] * f; } } }
    }
    {
        const unsigned short* Kg = KVg + (size_t)4 * (2 * MiB); const unsigned short* Vg = KVg + (size_t)5 * (2 * MiB);
        const int j_lo = (i >= 8) ? i - 8 : 0, NT = i - j_lo + 1, qm = trow - 4 * hi;
        float m_reg = -1e30f, l_reg = 0.f, mn, al;
#pragma unroll
        for (int d = 0; d < 4; ++d) o[d] = f32x16{};
        ATT_STG_LOAD(Kg, Vg, 64 * j_lo, true);
        for (int t = 0; t < NT; ++t) {
            const int kb = 64 * (j_lo + t);
            __syncthreads(); ATT_STG_WRITE(true); __syncthreads();
            if (t + 1 < NT) ATT_STG_LOAD(Kg, Vg, kb + 64, true);
            qkt<0, false>(p0, p1, K_lds, r32, hi, qr, true);
            if (kb + 63 > tw0 || tw0 + 31 - kb >= WINDOW) mask_tile(p0, p1, qm - kb, (unsigned)WINDOW);
            partialSM(p0, p1, m_reg, mn, al);
            finishSM(p0, p1, al, l_reg, pa0, pa1, pa2, pa3); SBAR();
            ATT_RESC(al);
            pv_tile<0, false>(o, vb0, pa0, pa1, pa2, pa3, true);
        }
        if (hi == 0) li_l[r32] = GT[2] / l_reg;
        asm volatile("s_waitcnt lgkmcnt(0)" ::: "memory");
        { int hi_o = hi; float* OAp = OA; asm volatile("" : "+v"(hi_o), "+v"(OAp));
#pragma unroll
        for (int r = 0; r < 16; ++r) { const int orow = crow(r, hi_o); const float f = li_l[orow];
#pragma unroll
            for (int d0 = 0; d0 < 4; ++d0) { float* pp_ = OAp + (size_t)orow * NSA_W + d0 * 32; *pp_ = __hip_atomic_load(pp_, __ATOMIC_RELAXED, __HIP_MEMORY_SCOPE_AGENT) + o[d0][r] * f; } } }
    }
    __syncthreads();
}
#undef ATT_STG_LOAD
#undef ATT_STG_WRITE
#undef ATT_RESC
#undef ATT_PK4
#undef KSWZ
#undef SBAR
}
enum { PH_FF1_GU = 1, PH_FF1_D, PH_THIN1, PH_WIN, PH_MIXA, PH_MIXB, PH_MIXC, PH_WOUT, PH_THIN2, PH_FF2_GU, PH_FF2_D, PH_THIN3, PH_PLE, PH_THIN4, PH_END };

__global__ void __launch_bounds__(NWAVES * 64, 2) mk_fwd(Args args) {
    extern __shared__ __attribute__((aligned(16))) unsigned char lds[];
    Frame F;
    F.lds = (LAS unsigned char*)lds;
    F.MISC = (volatile LAS unsigned*)(F.lds + MISC_OFF);
    F.tid = threadIdx.x; F.lane = F.tid & 63; F.wave = __builtin_amdgcn_readfirstlane(F.tid >> 6);
    F.G = gridDim.x; { const int bx = blockIdx.x; F.vcu = (F.G % 8 == 0) ? (bx % 8) * (F.G / 8) + bx / 8 : bx; }
    unsigned char* ws = args.ws;
    F.ctl = (gu32*)(ws + WS_CTL);
    for (int u = F.tid; u < (LDS_BYTES - LDSCTL_OFF) / 4; u += NWAVES * 64) ((LAS unsigned*)(F.lds + LDSCTL_OFF))[u] = 0u;
    __syncthreads();
    XcdBarrier bar = xcd_barrier_post((unsigned*)(F.ctl + CW_BAR) + args.li * XCD_BAR_WORDS, F.MISC + 8);
    const int lo = args.ph_lo, hi = args.ph_hi;
    auto INF = [&](int i) { return (const float*)args.in[i]; };
#define IN(k) (lo <= (k) && (k) < hi)
#define SEAM(k) do { if (IN(k) && IN((k) + 1)) xcd_barrier(bar); } while (0)

    if (args.jobmask) {
        p0_prologue(F, args);
        cg::this_grid().sync();
    }
    if (IN(PH_FF1_GU)) {
        pg8::Gemm g{(const bf16*)(ws + WS_U), (const bf16*)(ws + WS_WF1GU), MTOK, 2 * D_FF, D_MODEL};
        pg8::StaticOrder S; S.init(MTOK, 2 * D_FF, F.G, (int)blockIdx.x);
        EpiSwiGLU E{(bf16*)(ws + WS_ACT), D_FF};
        pg8::gemm_phase<EpiSwiGLU, pg8::StaticOrder, true, true>(F.lds + RING_OFF, g, S, E);
        SEAM(PH_FF1_GU);
    }
    if (IN(PH_FF1_D)) {
        pg8::Gemm g{(const bf16*)(ws + WS_ACT), (const bf16*)(ws + WS_WF1D), MTOK, D_MODEL, D_FF};
        pg8::StaticOrder S; S.init(MTOK, D_MODEL, F.G, (int)blockIdx.x);
        EpiF32 E{(float*)(ws + WS_YZ), D_MODEL};
        pg8::gemm_phase<EpiF32, pg8::StaticOrder, true, true>(F.lds + RING_OFF, g, S, E);
        SEAM(PH_FF1_D);
    }
    if (IN(PH_THIN1)) { thin_phase(F, INF(0), (const float*)(ws + WS_YZ), INF(4), 0.5f, args.out, INF(8), (bf16*)(ws + WS_U)); SEAM(PH_THIN1); }
    if (IN(PH_WIN)) {
        pg8::Gemm g{(const bf16*)(ws + WS_U), (const bf16*)(ws + WS_WIN), MTOK, N_IN_PAD, D_MODEL};
        pg8::StaticOrder S; S.init(MTOK, N_IN_PAD, F.G, (int)blockIdx.x);
        EpiWin E{ws + WS_YZ, (const float*)(ws + WS_TAB), INF(17)};
        pg8::gemm_phase<EpiWin, pg8::StaticOrder, true, true>(F.lds + RING_OFF, g, S, E);
        SEAM(PH_WIN);
    }
    if (IN(PH_MIXA)) {
        if (args.sub & SUB_CMP) for (int it = (int)blockIdx.x; it < 128; it += F.G) compress_unit(F, args, it);
        if (args.sub & SUB_LRU) for (int it = (int)blockIdx.x - 128; it < 128; it += F.G) { if (it >= 0) rglru_local_unit(F, args, it); }
        SEAM(PH_MIXA);
    }
    if (IN(PH_MIXB)) {
        if (args.sub & SUB_ATT) for (int it = (int)blockIdx.x; it < 256; it += F.G) att::attn_unit(F, args, it);
        if (args.sub & SUB_FIN) for (int it = (int)blockIdx.x; it < 128; it += F.G) rglru_final_unit(F, args, it);
        SEAM(PH_MIXB);
    }
    if (IN(PH_MIXC)) { oattn_norm_phase(F, args); SEAM(PH_MIXC); }
    if (IN(PH_WOUT)) {
        pg8::Gemm g{(const bf16*)(ws + WS_U), (const bf16*)(ws + WS_WOUT), MTOK, D_MODEL, D_MODEL};
        pg8::StaticOrder S; S.init(MTOK, D_MODEL, F.G, (int)blockIdx.x);
        EpiF32 E{(float*)(ws + WS_YZ), D_MODEL};
        pg8::gemm_phase<EpiF32, pg8::StaticOrder, true, true>(F.lds + RING_OFF, g, S, E);
        SEAM(PH_WOUT);
    }
    if (IN(PH_THIN2)) { thin_phase(F, args.out, (const float*)(ws + WS_YZ), INF(9), 1.0f, args.out, INF(28), (bf16*)(ws + WS_U)); SEAM(PH_THIN2); }
    if (IN(PH_FF2_GU)) {
        pg8::Gemm g{(const bf16*)(ws + WS_U), (const bf16*)(ws + WS_WF2GU), MTOK, 2 * D_FF, D_MODEL};
        pg8::StaticOrder S; S.init(MTOK, 2 * D_FF, F.G, (int)blockIdx.x);
        EpiSwiGLU E{(bf16*)(ws + WS_ACT), D_FF};
        pg8::gemm_phase<EpiSwiGLU, pg8::StaticOrder, true, true>(F.lds + RING_OFF, g, S, E);
        SEAM(PH_FF2_GU);
    }
    if (IN(PH_FF2_D)) {
        pg8::Gemm g{(const bf16*)(ws + WS_ACT), (const bf16*)(ws + WS_WF2D), MTOK, D_MODEL, D_FF};
        pg8::StaticOrder S; S.init(MTOK, D_MODEL, F.G, (int)blockIdx.x);
        EpiF32 E{(float*)(ws + WS_YZ), D_MODEL};
        pg8::gemm_phase<EpiF32, pg8::StaticOrder, true, true>(F.lds + RING_OFF, g, S, E);
        SEAM(PH_FF2_D);
    }
    if (IN(PH_THIN3)) { thin_phase(F, args.out, (const float*)(ws + WS_YZ), INF(29), 0.5f, args.out, INF(33), (bf16*)(ws + WS_U)); SEAM(PH_THIN3); }
    if (IN(PH_PLE)) {
        {
            pg8::Gemm g{(const bf16*)(ws + WS_P16), (const bf16*)(ws + WS_WPP), MTOK, D_MODEL, PLE_DIM};
            pg8::StaticOrder S; S.init(MTOK, D_MODEL, F.G, (int)blockIdx.x);
            EpiF32 E{(float*)(ws + WS_YZ), D_MODEL};
            pg8::gemm_phase<EpiF32, pg8::StaticOrder, true, true>(F.lds + RING_OFF, g, S, E);
        }
        asm volatile("s_waitcnt vmcnt(0)" ::: "memory"); __syncthreads();
        {
            pg8::Gemm g{(const bf16*)(ws + WS_U), (const bf16*)(ws + WS_WPG), MTOK, D_MODEL, D_MODEL};
            pg8::StaticOrder S; S.init(MTOK, D_MODEL, F.G, (int)blockIdx.x);
            EpiPle E{(float*)(ws + WS_YZ), D_MODEL};
            pg8::gemm_phase<EpiPle, pg8::StaticOrder, true, true>(F.lds + RING_OFF, g, S, E);
        }
        SEAM(PH_PLE);
    }
    if (IN(PH_THIN4)) { thin_phase(F, args.out, (const float*)(ws + WS_YZ), INF(34), 1.0f, args.out, nullptr, nullptr); }
#undef IN
#undef SEAM
}

static int mk_grid() {
    static int grid = 0;
    if (grid == 0) {
        int dev = 0, cus = 0, per_cu = 0;
        if (hipGetDevice(&dev) != hipSuccess || hipDeviceGetAttribute(&cus, hipDeviceAttributeMultiprocessorCount, dev) != hipSuccess) { fprintf(stderr, "mk_grid: device query failed\n"); grid = -1; return grid; }
        if (hipFuncSetAttribute((const void*)mk_fwd, hipFuncAttributeMaxDynamicSharedMemorySize, LDS_BYTES) != hipSuccess) { fprintf(stderr, "mk_grid: hipFuncSetAttribute failed\n"); grid = -1; return grid; }
        if (hipOccupancyMaxActiveBlocksPerMultiprocessor(&per_cu, (const void*)mk_fwd, NWAVES * 64, LDS_BYTES) != hipSuccess || per_cu < 1) { fprintf(stderr, "mk_grid: occupancy query failed (%d)\n", per_cu); (void)hipGetLastError(); grid = -1; return grid; }
        grid = cus * per_cu;
        fprintf(stderr, "mk_grid: %d CUs x %d blocks/CU -> grid %d\n", cus, per_cu, grid);
    }
    return grid;
}
static void mk_launch(hipStream_t stream, void* const* d_in, void* d_out, void* d_ws, int lo, int hi, int li, int jobmask, int sub = SUB_ALL) {
    const int grid = mk_grid(); if (grid <= 0) return;
    Args a{};
    for (int i = 0; i < 37; ++i) a.in[i] = d_in[i];
    a.out = (float*)d_out; a.ws = (unsigned char*)d_ws; a.ph_lo = lo; a.ph_hi = hi; a.li = li; a.jobmask = jobmask; a.sub = sub; a.pad = 0;
    void* kargs[] = {&a};
    hipError_t e = hipLaunchCooperativeKernel((const void*)mk_fwd, dim3(grid), dim3(NWAVES * 64), kargs, LDS_BYTES, stream);
    if (e != hipSuccess) fprintf(stderr, "mk_launch: cooperative launch failed: %s (grid %d)\n", hipGetErrorString(e), grid);
}

extern "C" void kernel_launch(void* const* d_in, const int* in_sizes, int n_in, void* d_out, int out_size, void* d_ws, size_t ws_size, hipStream_t stream) {
    if (n_in != 37 || out_size != MTOK * D_MODEL || ws_size < WS_END) { fprintf(stderr, "kernel_launch: unexpected n_in %d / out_size %d / ws_size %zu\n", n_in, out_size, ws_size); return; }
    (void)hipMemsetAsync((char*)d_ws + WS_CTL, 0, CTL_ZERO_BYTES, stream);
    mk_launch(stream, d_in, d_out, d_ws, PH_FF1_GU, PH_END, 0, JM_ALL, SUB_ALL);
}
```
